# Optimizing an MI355X kernel written in HIP

```python
import jax, jax.numpy as jnp
from jax import lax
import numpy as np

D_MODEL = 1024
BATCH = 2
SEQ = 16384
DEPTH = 2

D_MIX = D_MODEL
EPS = 1e-6
NEG = -1e30
FORCED = 1e6

NSA_DH = 64
NSA_W = D_MIX // 2
NSA_HQ = NSA_W // NSA_DH
NSA_HKV = 2
NSA_G = NSA_HQ // NSA_HKV
KV_W = NSA_HKV * NSA_DH
CMP_BLOCK = 32
CMP_STRIDE = 16
CMP_HID = 128
SLC_BLOCK = 64
N_SEL = 16
WINDOW = 512
Q_BLOCK = 128

LRU_W = D_MIX // 4
LRU_HEADS = 8
LRU_BW = LRU_W // LRU_HEADS
LRU_CONV = 4
LRU_C = 8.0

CV_W = D_MIX // 4
CV_KERNEL = 31

D_FF = 4 * D_MODEL

OFF_Q = 0
OFF_KV = OFF_Q + NSA_W
OFF_GATE = OFF_KV + 6 * KV_W
OFF_LRU_X = OFF_GATE + 3 * NSA_HQ
OFF_LRU_G = OFF_LRU_X + LRU_W
OFF_CV = OFF_LRU_G + LRU_W
N_IN = OFF_CV + 2 * CV_W

kernel_name = "hymba_nsa_rglru_conformer_trunk"


def rms_norm(x, g):
    xf = x.astype(jnp.float32)
    y = xf * lax.rsqrt(jnp.mean(xf * xf, axis=-1, keepdims=True) + EPS)
    return (y * g.astype(jnp.float32)).astype(x.dtype)


def layer_norm(x, g, b):
    xf = x.astype(jnp.float32)
    mu = jnp.mean(xf, axis=-1, keepdims=True)
    var = jnp.mean(jnp.square(xf - mu), axis=-1, keepdims=True)
    y = (xf - mu) * lax.rsqrt(var + EPS)
    return (y * g.astype(jnp.float32) + b.astype(jnp.float32)).astype(x.dtype)


def causal_depthwise_conv(x, w, b):
    k = w.shape[0]
    y = lax.conv_general_dilated(
        x, w[:, None, :].astype(x.dtype), window_strides=(1,), padding=[(k - 1, 0)],
        dimension_numbers=('NWC', 'WIO', 'NWC'), feature_group_count=x.shape[-1])
    return y + b.astype(x.dtype)


def compress(kv, pos, w1, w2):
    b, s, h, dh = kv.shape
    c = kv.reshape(b, s // CMP_STRIDE, CMP_STRIDE, h, dh)
    blocks = jnp.concatenate([c[:, :-1], c[:, 1:]], axis=2)
    blocks = blocks + pos[None, None, :, None, :].astype(kv.dtype)
    nc = blocks.shape[1]
    flat = blocks.transpose(0, 1, 3, 2, 4).reshape(b, nc, h, CMP_BLOCK * dh)
    return jax.nn.gelu(flat @ w1) @ w2


def nsa_attention(q, kc, vc, ks, vs, kw, vw, gates):
    b, h, g, s, dh = q.shape
    nc = kc.shape[2]
    n_slc = s // SLC_BLOCK
    n_sel = min(N_SEL, n_slc)
    ratio = SLC_BLOCK // CMP_STRIDE
    scale = dh ** -0.5
    ks_b = ks.reshape(b, h, n_slc, SLC_BLOCK, dh)
    vs_b = vs.reshape(b, h, n_slc, SLC_BLOCK, dh)
    kw_p = jnp.pad(kw, ((0, 0), (0, 0), (WINDOW, 0), (0, 0)))
    vw_p = jnp.pad(vw, ((0, 0), (0, 0), (WINDOW, 0), (0, 0)))
    cmp_end = jnp.arange(nc) * CMP_STRIDE + CMP_BLOCK - 1
    blk = jnp.arange(n_slc)
    gather = jax.vmap(jax.vmap(lambda kb, ix: kb[ix]))

    def block_fn(i):
        start = i * Q_BLOCK
        t = start + jnp.arange(Q_BLOCK)
        qb = lax.dynamic_slice_in_dim(q, start, Q_BLOCK, axis=3)
        gb = lax.dynamic_slice_in_dim(gates, start, Q_BLOCK, axis=3).astype(jnp.float32)

        s_c = jnp.einsum('bhgqd,bhnd->bhgqn', qb, kc).astype(jnp.float32) * scale
        m_c = cmp_end[None, :] <= t[:, None]
        p_c = jax.nn.softmax(jnp.where(m_c, s_c, NEG), axis=-1) * m_c
        o_c = jnp.einsum('bhgqn,bhnd->bhgqd', p_c.astype(vc.dtype), vc)

        imp = p_c.sum(axis=2)
        imp = jnp.pad(imp, ((0, 0), (0, 0), (0, 0), (1, ratio)))
        imp_slc = (imp[..., :ratio * n_slc].reshape(b, h, Q_BLOCK, n_slc, ratio).sum(-1)
                   + imp[..., ratio::ratio])
        cur = t // SLC_BLOCK
        valid = blk[None, :] * SLC_BLOCK <= t[:, None]
        forced = ((blk[None, :] == 0) | (blk[None, :] == cur[:, None])
                  | (blk[None, :] == cur[:, None] - 1))
        score = jnp.where(valid, jnp.where(forced, FORCED, imp_slc), NEG)
        _, idx = lax.top_k(score, n_sel)

        k_sel = gather(ks_b, idx)
        v_sel = gather(vs_b, idx)
        s_s = jnp.einsum('bhgqd,bhqnld->bhgqnl', qb, k_sel).astype(jnp.float32) * scale
        pos = idx[..., None] * SLC_BLOCK + jnp.arange(SLC_BLOCK)
        m_s = (pos <= t[:, None, None])[:, :, None]
        s_s = jnp.where(m_s, s_s, NEG).reshape(b, h, g, Q_BLOCK, n_sel * SLC_BLOCK)
        p_s = jax.nn.softmax(s_s, axis=-1).reshape(b, h, g, Q_BLOCK, n_sel, SLC_BLOCK)
        o_s = jnp.einsum('bhgqnl,bhqnld->bhgqd', p_s.astype(v_sel.dtype), v_sel)

        kwb = lax.dynamic_slice_in_dim(kw_p, start, WINDOW + Q_BLOCK, axis=2)
        vwb = lax.dynamic_slice_in_dim(vw_p, start, WINDOW + Q_BLOCK, axis=2)
        s_w = jnp.einsum('bhgqd,bhkd->bhgqk', qb, kwb).astype(jnp.float32) * scale
        kpos = start - WINDOW + jnp.arange(WINDOW + Q_BLOCK)
        m_w = ((kpos[None, :] <= t[:, None]) & (kpos[None, :] > t[:, None] - WINDOW)
               & (kpos[None, :] >= 0))
        p_w = jax.nn.softmax(jnp.where(m_w, s_w, NEG), axis=-1)
        o_w = jnp.einsum('bhgqk,bhkd->bhgqd', p_w.astype(vwb.dtype), vwb)

        o = gb[..., 0:1] * o_c + gb[..., 1:2] * o_s + gb[..., 2:3] * o_w
        return o.astype(q.dtype)

    out = lax.map(block_fn, jnp.arange(s // Q_BLOCK))
    return out.transpose(1, 0, 4, 2, 3, 5).reshape(b, s, h * g * dh)


def rglru(xb, gb, conv_w, conv_b, wa, ba, wx, bx, lam):
    b, s, w = xb.shape
    xr = causal_depthwise_conv(xb, conv_w, conv_b)
    xh = xr.reshape(b, s, LRU_HEADS, LRU_BW)
    r = jax.nn.sigmoid(jnp.einsum('bshi,hij->bshj', xh, wa).reshape(b, s, w).astype(jnp.float32)
                       + ba.astype(jnp.float32))
    ig = jax.nn.sigmoid(jnp.einsum('bshi,hij->bshj', xh, wx).reshape(b, s, w).astype(jnp.float32)
                        + bx.astype(jnp.float32))
    log_a = -LRU_C * r * jax.nn.softplus(-lam.astype(jnp.float32))
    a = jnp.exp(log_a)
    mult = jnp.sqrt(-jnp.expm1(2.0 * log_a))
    u = xr.astype(jnp.float32) * ig * mult

    def combine(c1, c2):
        a1, b1 = c1
        a2, b2 = c2
        return a1 * a2, a2 * b1 + b2

    _, hseq = lax.associative_scan(combine, (a, u), axis=1)
    return (hseq * jax.nn.gelu(gb.astype(jnp.float32))).astype(xb.dtype)


def conformer_conv(u, dw_w, dw_b, ln_g, ln_b):
    a, gt = jnp.split(u, 2, axis=-1)
    y = a * jax.nn.sigmoid(gt)
    y = causal_depthwise_conv(y, dw_w, dw_b)
    y = layer_norm(y, ln_g, ln_b)
    return jax.nn.silu(y)


def setup_inputs(seed: int = 0) -> dict:
    key = jax.random.key(seed)
    ks = jax.random.split(key, 32)
    f32 = jnp.float32
    nrm = lambda k, shape, scale: jax.random.normal(k, shape, f32) * scale
    u = jax.random.uniform(ks[20], (DEPTH, LRU_W), f32, minval=0.9, maxval=0.999)
    p = u ** (1.0 / LRU_C)
    return {
        "x": jax.random.normal(ks[0], (BATCH, SEQ, D_MODEL), f32),
        "attn_norm": 1.0 + nrm(ks[1], (DEPTH, D_MODEL), 0.02),
        "w_in": nrm(ks[2], (DEPTH, D_MODEL, N_IN), D_MODEL ** -0.5),
        "q_norm": 1.0 + nrm(ks[3], (DEPTH, NSA_DH), 0.02),
        "k_norm": 1.0 + nrm(ks[4], (DEPTH, 3, NSA_DH), 0.02),
        "cmp_pos": nrm(ks[5], (DEPTH, 2, CMP_BLOCK, NSA_DH), 0.1),
        "cmp_w1": nrm(ks[6], (DEPTH, 2, CMP_BLOCK * NSA_DH, CMP_HID), (CMP_BLOCK * NSA_DH) ** -0.5),
        "cmp_w2": nrm(ks[7], (DEPTH, 2, CMP_HID, NSA_DH), CMP_HID ** -0.5),
        "lru_conv_w": nrm(ks[8], (DEPTH, LRU_CONV, LRU_W), LRU_CONV ** -0.5),
        "lru_conv_b": nrm(ks[9], (DEPTH, LRU_W), 0.02),
        "lru_wa": nrm(ks[10], (DEPTH, LRU_HEADS, LRU_BW, LRU_BW), LRU_BW ** -0.5),
        "lru_ba": nrm(ks[11], (DEPTH, LRU_W), 0.02),
        "lru_wx": nrm(ks[12], (DEPTH, LRU_HEADS, LRU_BW, LRU_BW), LRU_BW ** -0.5),
        "lru_bx": nrm(ks[13], (DEPTH, LRU_W), 0.02),
        "lru_lambda": jnp.log(p) - jnp.log1p(-p),
        "cv_dw_w": nrm(ks[14], (DEPTH, CV_KERNEL, CV_W), CV_KERNEL ** -0.5),
        "cv_dw_b": nrm(ks[15], (DEPTH, CV_W), 0.02),
        "cv_ln_g": 1.0 + nrm(ks[16], (DEPTH, CV_W), 0.02),
        "cv_ln_b": nrm(ks[17], (DEPTH, CV_W), 0.02),
        "out_norm": 1.0 + nrm(ks[18], (DEPTH, D_MIX), 0.02),
        "w_out": nrm(ks[19], (DEPTH, D_MIX, D_MODEL), (2.0 * D_MIX) ** -0.5),
        "mlp_norm": 1.0 + nrm(ks[21], (DEPTH, D_MODEL), 0.02),
        "mlp_w1": nrm(ks[22], (DEPTH, D_MODEL, D_FF), D_MODEL ** -0.5),
        "mlp_w2": nrm(ks[23], (DEPTH, D_FF, D_MODEL), (2.0 * D_FF) ** -0.5),
    }


def reference(x, attn_norm, w_in, q_norm, k_norm, cmp_pos, cmp_w1, cmp_w2,
              lru_conv_w, lru_conv_b, lru_wa, lru_ba, lru_wx, lru_bx, lru_lambda,
              cv_dw_w, cv_dw_b, cv_ln_g, cv_ln_b, out_norm, w_out,
              mlp_norm, mlp_w1, mlp_w2):
    b, s, _ = x.shape
    for l in range(DEPTH):
        hn = rms_norm(x, attn_norm[l])
        z = hn @ w_in[l]

        q = rms_norm(z[..., OFF_Q:OFF_KV].reshape(b, s, NSA_HKV, NSA_G, NSA_DH), q_norm[l])
        q = q.transpose(0, 2, 3, 1, 4)
        kv = z[..., OFF_KV:OFF_GATE].reshape(b, s, 6, NSA_HKV, NSA_DH)
        kc = rms_norm(compress(kv[:, :, 0], cmp_pos[l, 0], cmp_w1[l, 0], cmp_w2[l, 0]), k_norm[l, 0])
        vc = compress(kv[:, :, 1], cmp_pos[l, 1], cmp_w1[l, 1], cmp_w2[l, 1])
        k_s = rms_norm(kv[:, :, 2], k_norm[l, 1])
        k_w = rms_norm(kv[:, :, 4], k_norm[l, 2])
        tr = lambda a: a.transpose(0, 2, 1, 3)
        gates = jax.nn.sigmoid(z[..., OFF_GATE:OFF_LRU_X].reshape(b, s, NSA_HKV, NSA_G, 3))
        gates = gates.transpose(0, 2, 3, 1, 4)
        y_attn = nsa_attention(q, tr(kc), tr(vc), tr(k_s), tr(kv[:, :, 3]),
                               tr(k_w), tr(kv[:, :, 5]), gates)

        y_lru = rglru(z[..., OFF_LRU_X:OFF_LRU_G], z[..., OFF_LRU_G:OFF_CV],
                      lru_conv_w[l], lru_conv_b[l], lru_wa[l], lru_ba[l],
                      lru_wx[l], lru_bx[l], lru_lambda[l])

        y_cv = conformer_conv(z[..., OFF_CV:N_IN], cv_dw_w[l], cv_dw_b[l],
                              cv_ln_g[l], cv_ln_b[l])

        g_out = out_norm[l]
        y = jnp.concatenate([
            rms_norm(y_attn, g_out[:NSA_W]),
            rms_norm(y_lru, g_out[NSA_W:NSA_W + LRU_W]),
            rms_norm(y_cv, g_out[NSA_W + LRU_W:]),
        ], axis=-1)
        x = x + y @ w_out[l]

        hm = rms_norm(x, mlp_norm[l])
        x = x + jnp.square(jax.nn.relu(hm @ mlp_w1[l])) @ mlp_w2[l]
    return x
```

```cpp
#include <hip/hip_runtime.h>
#include <cstdio>
#include <cstdint>

constexpr int D_MODEL = 1024, BATCH = 2, SEQ = 16384, MTOK = BATCH * SEQ, N_IN = 2328, NZ = 2304, D_FF = 4096;
constexpr int ZQ = 0, ZKV = 512, ZLX = 1280, ZLG = 1536, ZCV = 1792;
constexpr int OFF_GATE_SRC = 1280, OFF_LRU_SRC = 1304;
constexpr int NC = 1023, NSLC = 256;

typedef unsigned short bf16_t;
__device__ __forceinline__ unsigned f2bf(float f) { unsigned u = __builtin_bit_cast(unsigned, f); return (u + 0x7fffu + ((u >> 16) & 1u)) >> 16; }
__device__ __forceinline__ float bf2f(unsigned short h) { return __builtin_bit_cast(float, (unsigned)h << 16); }
__device__ __forceinline__ float wave_sum(float v) {
#pragma unroll
    for (int o = 1; o < 64; o <<= 1) v += __shfl_xor(v, o);
    return v;
}
__device__ __forceinline__ float gelu_tanh(float x) { const float u = 0.7978845608028654f * (x + 0.044715f * x * x * x); return 0.5f * x * (1.f + tanhf(u)); }
__device__ __forceinline__ float sigmoidf_(float x) { return 1.f / (1.f + __expf(-x)); }

namespace pg8 {
#define PG8_LAS __attribute__((address_space(3)))
using ::bf16_t;
typedef short bf16x8 __attribute__((ext_vector_type(8)));
typedef float f32x4 __attribute__((ext_vector_type(4)));
typedef unsigned u32x4 __attribute__((ext_vector_type(4)));
constexpr int BM = 256, BK = 64, HALF = 128, HTB = HALF * BK * 2  , STAGE_BYTES = 8 * HTB, NXCD = 8, WGM = 8;

__host__ __device__ __forceinline__ int lds_byte(int r, int c) { const int st = (r >> 4) * 2 + (c >> 5), rr = r & 15, cc = c & 31, ob = rr * 64 + cc * 2; return st * 1024 + (ob ^ (((ob >> 9) & 1) << 5)); }
__host__ __device__ __forceinline__ void stage_rc(int b, int& R, int& C) { const int st = b / 1024, sb = b % 1024, swz = sb ^ (((sb >> 9) & 1) << 5); R = (st >> 1) * 16 + swz / 64; C = (st & 1) * 32 + (swz % 64) / 2; }
__host__ __device__ __forceinline__ int perm32(int rho) { const int n = rho >> 4, i = rho & 15; return 8 * (i >> 2) + 4 * n + (i & 3); }

struct Unit { int pm, pn; };
struct Gemm { const bf16_t* A; const bf16_t* Bt; int M, N, K, pad; };

struct StaticOrder {
    int nM, nN, nwg, G, c;
    __host__ __device__ void init(int M, int N, int G_, int c_) { nM = M / BM; nN = N / BM; nwg = nM * nN; G = G_; c = c_; }
    __host__ __device__ bool next(int i, Unit& u) const {
        const long L = (long)i * G + c; if (L >= nwg) return false;
        int wgid = (int)L; { const int q = nwg / NXCD, r = nwg % NXCD, xcd = wgid % NXCD, off = wgid / NXCD; wgid = (xcd < r ? xcd * (q + 1) : r * (q + 1) + (xcd - r) * q) + off; }
        const int nig = WGM * nN, gid = wgid / nig, fm = gid * WGM, gsz = (nM - fm) < WGM ? (nM - fm) : WGM;
        u.pm = fm + ((wgid % nig) % gsz); u.pn = (wgid % nig) / gsz; return true;
    }
    __device__ __forceinline__ void a_ready(const Unit&) const {}
    __device__ __forceinline__ void done(const Unit&) const {}
};


__device__ __forceinline__ unsigned cvt_pk_bf16(float lo, float hi) { unsigned r; asm volatile("v_cvt_pk_bf16_f32 %0, %1, %2" : "=v"(r) : "v"(lo), "v"(hi)); return r; }

template <int ACT  > struct EpiBf16 {
    static constexpr bool PERM = true, AFTER_DRAIN = false;
    bf16_t* O; int ldc, pad;
    __device__ __forceinline__ void operator()(const f32x4 (&acc)[2][2][4][2], const Unit& u, int wr, int wc, int fr, int fq) const {
        const int row0 = u.pm * BM + wr * 64 + fr; const int col0 = u.pn * BM + wc * 32 + 8 * fq;
#pragma unroll
        for (int ai = 0; ai < 2; ++ai)
#pragma unroll
            for (int m = 0; m < 4; ++m) { bf16_t* rowp = O + (size_t)(row0 + ai * HALF + m * 16) * ldc + col0;
#pragma unroll
                for (int bj = 0; bj < 2; ++bj) { f32x4 v0 = acc[ai][bj][m][0], v1 = acc[ai][bj][m][1];
                    if (ACT == 2) {
#pragma unroll
                        for (int e = 0; e < 4; ++e) { float a = v0[e] > 0.f ? v0[e] : 0.f; v0[e] = a * a; float b = v1[e] > 0.f ? v1[e] : 0.f; v1[e] = b * b; } }
                    u32x4 w; w.x = cvt_pk_bf16(v0[0], v0[1]); w.y = cvt_pk_bf16(v0[2], v0[3]); w.z = cvt_pk_bf16(v1[0], v1[1]); w.w = cvt_pk_bf16(v1[2], v1[3]);
                    *(u32x4*)(rowp + bj * HALF) = w; } }
    }
};
struct EpiResF32 {
    static constexpr bool PERM = false, AFTER_DRAIN = false;
    const float* base; float* C; int ldc, pad;
    __device__ __forceinline__ void operator()(const f32x4 (&acc)[2][2][4][2], const Unit& u, int wr, int wc, int fr, int fq) const {
        const int row0 = u.pm * BM + wr * 64 + fr, col0 = u.pn * BM + wc * 32 + 4 * fq;
#pragma unroll
        for (int ai = 0; ai < 2; ++ai)
#pragma unroll
            for (int m = 0; m < 4; ++m) { const size_t off = (size_t)(row0 + ai * HALF + m * 16) * ldc + col0;
#pragma unroll
                for (int bj = 0; bj < 2; ++bj)
#pragma unroll
                    for (int n = 0; n < 2; ++n) { const f32x4 b = *(const f32x4*)(base + off + bj * HALF + n * 16); *(f32x4*)(C + off + bj * HALF + n * 16) = acc[ai][bj][m][n] + b; } }
    }
};

template <class Epi, class Sched, bool ALIGN_EPI = false, bool SP2 = false>
__device__ __forceinline__ void gemm_phase(PG8_LAS unsigned char* lds, const Gemm g, const Sched& S, const Epi& E) {
    const int tid = threadIdx.x, wid = __builtin_amdgcn_readfirstlane(tid >> 6), lane = tid & 63, wr = wid >> 2, wc = wid & 3, fr = lane & 15, fq = lane >> 4;
    const int K = g.K, nt = K / BK;
    unsigned voffA[2], voffB[2];
#pragma unroll
    for (int i = 0; i < 2; ++i) { int R, C; stage_rc(tid * 16 + i * 8192, R, C); const int Rb = Epi::PERM ? ((R & ~31) + perm32(R & 31)) : R;
        voffA[i] = (unsigned)(R * K + C) * 2u; voffB[i] = (unsigned)(Rb * K + C) * 2u; }
    const size_t kstep = (size_t)(BK * 2);
    const size_t hstep = (size_t)HALF * K * 2;
    const size_t tstep = 2 * hstep;
    const unsigned ldsw = (unsigned)wid * 1024u;
    const int aoff = lds_byte(wr * 64 + fr, fq * 8), boff = lds_byte(wc * 32 + fr, fq * 8);
#define PG8_SA(b, h) (((b) * 2 + (h)) * HTB)
#define PG8_SB(b, h) ((4 + (b) * 2 + (h)) * HTB)
#define PG8_STAGE(bufoff, gbase, voff) do { _Pragma("unroll") for (int _i = 0; _i < 2; ++_i) \
        __builtin_amdgcn_global_load_lds((const unsigned*)((const char*)(gbase) + (voff)[_i]), (PG8_LAS unsigned*)(lds + (bufoff) + ldsw + _i * 8192), 16, 0, 0); } while (0)
#define PG8_LDA(dst, b, h) do { _Pragma("unroll") for (int m = 0; m < 4; ++m) _Pragma("unroll") for (int k = 0; k < 2; ++k) dst[m][k] = *(const PG8_LAS bf16x8*)(lds + PG8_SA(b, h) + aoff + m * 2048 + k * 1024); } while (0)
#define PG8_LDB(dst, b, h) do { _Pragma("unroll") for (int n = 0; n < 2; ++n) _Pragma("unroll") for (int k = 0; k < 2; ++k) dst[n][k] = *(const PG8_LAS bf16x8*)(lds + PG8_SB(b, h) + boff + n * 2048 + k * 1024); } while (0)
#define PG8_MMA(ai, bj, At, Bt) do { __builtin_amdgcn_s_setprio(1); _Pragma("unroll") for (int m = 0; m < 4; ++m) _Pragma("unroll") for (int n = 0; n < 2; ++n) _Pragma("unroll") for (int k = 0; k < 2; ++k) \
        acc[ai][bj][m][n] = __builtin_amdgcn_mfma_f32_16x16x32_bf16(Bt[n][k], At[m][k], acc[ai][bj][m][n], 0, 0, 0); __builtin_amdgcn_s_setprio(0); } while (0)
#define PG8_WAIT_V(n) asm volatile("s_waitcnt vmcnt(" #n ")" ::: "memory")
#define PG8_WAIT_L(n) asm volatile("s_waitcnt lgkmcnt(" #n ")" ::: "memory")
#define PG8_BAR __builtin_amdgcn_s_barrier()
#define PG8_SCHED __builtin_amdgcn_sched_barrier(0)
    Unit cur, nxt; int ui = 0;
    if (!S.next(0, cur)) return;
    f32x4 acc[2][2][4][2];
#pragma unroll
    for (int a = 0; a < 2; ++a)
#pragma unroll
        for (int b = 0; b < 2; ++b)
#pragma unroll
            for (int m = 0; m < 4; ++m)
#pragma unroll
                for (int n = 0; n < 2; ++n) acc[a][b][m][n] = (f32x4){0.f, 0.f, 0.f, 0.f};
    bf16x8 At[4][2], B0[2][2], B1[2][2];
    const char* cA = (const char*)g.A + (size_t)cur.pm * tstep; const char* cB = (const char*)g.Bt + (size_t)cur.pn * tstep;
    S.a_ready(cur);
    if constexpr (SP2) {
        PG8_STAGE(PG8_SB(0, 0), cB, voffB); PG8_STAGE(PG8_SB(0, 1), cB + hstep, voffB); PG8_STAGE(PG8_SA(0, 0), cA, voffA); PG8_STAGE(PG8_SA(0, 1), cA + hstep, voffA);
        if (wr == 1) PG8_BAR;
        PG8_WAIT_V(2); PG8_BAR;
        PG8_STAGE(PG8_SB(1, 0), cB + kstep, voffB); PG8_STAGE(PG8_SA(1, 0), cA + kstep, voffA); PG8_STAGE(PG8_SB(1, 1), cB + hstep + kstep, voffB);
        PG8_WAIT_V(6); PG8_BAR;
    } else {
        PG8_STAGE(PG8_SB(0, 0), cB, voffB); PG8_STAGE(PG8_SA(0, 0), cA, voffA); PG8_STAGE(PG8_SB(0, 1), cB + hstep, voffB); PG8_STAGE(PG8_SA(0, 1), cA + hstep, voffA);
        if (wr == 1) PG8_BAR;
        PG8_WAIT_V(4); PG8_BAR;
        PG8_STAGE(PG8_SB(1, 0), cB + kstep, voffB); PG8_STAGE(PG8_SA(1, 0), cA + kstep, voffA); PG8_STAGE(PG8_SB(1, 1), cB + hstep + kstep, voffB);
        PG8_WAIT_V(6); PG8_BAR;
    }
    for (;;) {
        const bool has_next = S.next(ui + 1, nxt);
        const char* nA = has_next ? (const char*)g.A + (size_t)nxt.pm * tstep : cA; const char* nB = has_next ? (const char*)g.Bt + (size_t)nxt.pn * tstep : cB;
        for (int t = 0; t < nt; t += 2) {
            const bool last = (t == nt - 2);
            const char* a1 = cA + (size_t)(t + 1) * kstep;
            const char* a2 = last ? nA : cA + (size_t)(t + 2) * kstep; const char* b2 = last ? nB : cB + (size_t)(t + 2) * kstep;
            const char* a3 = a2 + kstep; const char* b3 = b2 + kstep;
            if (last && has_next) S.a_ready(nxt);
            if constexpr (SP2) {
            PG8_LDB(B0, 0, 0); PG8_LDB(B1, 0, 1); PG8_SCHED; PG8_LDA(At, 0, 0); PG8_STAGE(PG8_SA(1, 1), a1 + hstep, voffA);
            PG8_WAIT_V(8); PG8_WAIT_L(0); PG8_BAR; PG8_MMA(0, 0, At, B0); PG8_MMA(0, 1, At, B1); PG8_BAR; PG8_SCHED;
            PG8_LDA(At, 0, 1); PG8_STAGE(PG8_SB(0, 0), b2, voffB); PG8_STAGE(PG8_SB(0, 1), b2 + hstep, voffB); PG8_STAGE(PG8_SA(0, 0), a2, voffA);
            PG8_WAIT_V(8); PG8_WAIT_L(0); PG8_BAR; PG8_MMA(1, 0, At, B0); PG8_MMA(1, 1, At, B1); PG8_BAR; PG8_SCHED;
            PG8_LDB(B0, 1, 0); PG8_LDB(B1, 1, 1); PG8_SCHED; PG8_LDA(At, 1, 0); PG8_STAGE(PG8_SA(0, 1), a2 + hstep, voffA);
            PG8_WAIT_V(8); PG8_WAIT_L(0); PG8_BAR; PG8_MMA(0, 0, At, B0); PG8_MMA(0, 1, At, B1); PG8_BAR; PG8_SCHED;
            PG8_LDA(At, 1, 1); PG8_STAGE(PG8_SB(1, 0), b3, voffB); PG8_STAGE(PG8_SB(1, 1), b3 + hstep, voffB); PG8_STAGE(PG8_SA(1, 0), a3, voffA);
            PG8_WAIT_V(8); PG8_WAIT_L(0); PG8_BAR; PG8_MMA(1, 0, At, B0); PG8_MMA(1, 1, At, B1); PG8_BAR; PG8_SCHED;
            } else {
            PG8_LDB(B0, 0, 0); PG8_SCHED; PG8_LDA(At, 0, 0); PG8_STAGE(PG8_SA(1, 1), a1 + hstep, voffA);
            PG8_WAIT_L(8); PG8_BAR; PG8_WAIT_L(0); PG8_MMA(0, 0, At, B0); PG8_BAR; PG8_SCHED;
            PG8_LDB(B1, 0, 1); PG8_STAGE(PG8_SB(0, 0), b2, voffB);
            PG8_BAR; PG8_WAIT_L(0); PG8_MMA(0, 1, At, B1); PG8_BAR;
            PG8_LDA(At, 0, 1); PG8_STAGE(PG8_SA(0, 0), a2, voffA);
            PG8_BAR; PG8_WAIT_L(0); PG8_MMA(1, 0, At, B0); PG8_BAR; PG8_SCHED;
            PG8_STAGE(PG8_SB(0, 1), b2 + hstep, voffB);
            PG8_WAIT_V(6); PG8_BAR; PG8_MMA(1, 1, At, B1); PG8_BAR;
            PG8_LDB(B0, 1, 0); PG8_SCHED; PG8_LDA(At, 1, 0); PG8_STAGE(PG8_SA(0, 1), a2 + hstep, voffA);
            PG8_WAIT_L(8); PG8_BAR; PG8_WAIT_L(0); PG8_MMA(0, 0, At, B0); PG8_BAR; PG8_SCHED;
            PG8_LDB(B1, 1, 1); PG8_STAGE(PG8_SB(1, 0), b3, voffB);
            PG8_BAR; PG8_WAIT_L(0); PG8_MMA(0, 1, At, B1); PG8_BAR;
            PG8_LDA(At, 1, 1); PG8_STAGE(PG8_SA(1, 0), a3, voffA);
            PG8_BAR; PG8_WAIT_L(0); PG8_MMA(1, 0, At, B0); PG8_BAR; PG8_SCHED;
            PG8_STAGE(PG8_SB(1, 1), b3 + hstep, voffB);
            PG8_WAIT_V(6); PG8_BAR; PG8_MMA(1, 1, At, B1); PG8_BAR;
            }
        }
        if constexpr (ALIGN_EPI) { if (wr == 0) PG8_BAR; }
        if constexpr (!Epi::AFTER_DRAIN) { E(acc, cur, wr, wc, fr, fq); S.done(cur); }
        if (!has_next) break;
#pragma unroll
        for (int a = 0; a < 2; ++a)
#pragma unroll
            for (int b = 0; b < 2; ++b)
#pragma unroll
                for (int m = 0; m < 4; ++m)
#pragma unroll
                    for (int n = 0; n < 2; ++n) acc[a][b][m][n] = (f32x4){0.f, 0.f, 0.f, 0.f};
        cur = nxt; cA = nA; cB = nB; ++ui;
        if constexpr (ALIGN_EPI) { if (wr == 1) PG8_BAR; }
    }
    PG8_WAIT_V(0);
    if constexpr (!ALIGN_EPI) { if (wr == 0) PG8_BAR; }
    PG8_BAR;
    if constexpr (Epi::AFTER_DRAIN) { E.fused(acc, cur, wr, wc, fr, fq, lds, wid, lane); S.done(cur); }
#undef PG8_SA
#undef PG8_SB
#undef PG8_STAGE
#undef PG8_LDA
#undef PG8_LDB
#undef PG8_MMA
#undef PG8_WAIT_V
#undef PG8_WAIT_L
#undef PG8_BAR
#undef PG8_SCHED
}
}

template <class Epi>
__global__ void __launch_bounds__(512, 2) k_gemm(pg8::Gemm g, Epi E) {
    extern __shared__ __attribute__((aligned(16))) unsigned char lds_g[];
    pg8::StaticOrder S; S.init(g.M, g.N, (int)gridDim.x, (int)blockIdx.x);
    pg8::gemm_phase<Epi, pg8::StaticOrder, true, true>((PG8_LAS unsigned char*)lds_g, g, S, E);
}

__global__ void __launch_bounds__(256) k_transpose(const float* __restrict__ W, int K, int ldw, int col_off, bf16_t* __restrict__ WT, int row_off) {
    __shared__ float t[32][33];
    const int n0 = blockIdx.x * 32, k0 = blockIdx.y * 32, tx = threadIdx.x & 31, ty = threadIdx.x >> 5;
    for (int i = ty; i < 32; i += 8) t[i][tx] = W[(size_t)(k0 + i) * ldw + col_off + n0 + tx];
    __syncthreads();
    for (int i = ty; i < 32; i += 8) WT[(size_t)(row_off + n0 + i) * K + k0 + tx] = (bf16_t)f2bf(t[tx][i]);
}

__global__ void __launch_bounds__(256) k_rmsnorm(const float* __restrict__ x, const float* __restrict__ gamma, bf16_t* __restrict__ xn, float* __restrict__ rstd) {
    const int row = blockIdx.x * 4 + (threadIdx.x >> 6), lane = threadIdx.x & 63;
    const float4* xr = (const float4*)(x + (size_t)row * D_MODEL) + lane;
    float4 v[4]; float s = 0.f;
#pragma unroll
    for (int j = 0; j < 4; ++j) { v[j] = xr[64 * j]; s += (v[j].x * v[j].x + v[j].y * v[j].y) + (v[j].z * v[j].z + v[j].w * v[j].w); }
    const float r = rsqrtf(wave_sum(s) * (1.f / D_MODEL) + 1e-6f);
    if (lane == 0) rstd[row] = r;
    uint2* o = (uint2*)(xn + (size_t)row * D_MODEL) + lane;
#pragma unroll
    for (int j = 0; j < 4; ++j) { const float4 g = ((const float4*)gamma)[lane + 64 * j];
        uint2 w; w.x = f2bf(v[j].x * r * g.x) | (f2bf(v[j].y * r * g.y) << 16); w.y = f2bf(v[j].z * r * g.z) | (f2bf(v[j].w * r * g.w) << 16); o[64 * j] = w; }
}

__global__ void __launch_bounds__(192) k_gates(const float* __restrict__ x, const float* __restrict__ gamma, const float* __restrict__ w_in, const float* __restrict__ rstd, float* __restrict__ gates) {
    const int j = threadIdx.x % 24, slot = threadIdx.x / 24, m0 = blockIdx.x * 32 + slot * 4;
    float a0 = 0.f, a1 = 0.f, a2 = 0.f, a3 = 0.f;
    const float* x0 = x + (size_t)m0 * D_MODEL;
    for (int k = 0; k < D_MODEL; ++k) { const float w = w_in[(size_t)k * N_IN + OFF_GATE_SRC + j] * gamma[k];
        a0 += x0[k] * w; a1 += x0[D_MODEL + k] * w; a2 += x0[2 * D_MODEL + k] * w; a3 += x0[3 * D_MODEL + k] * w; }
    gates[(size_t)(m0 + 0) * 24 + j] = sigmoidf_(a0 * rstd[m0 + 0]); gates[(size_t)(m0 + 1) * 24 + j] = sigmoidf_(a1 * rstd[m0 + 1]);
    gates[(size_t)(m0 + 2) * 24 + j] = sigmoidf_(a2 * rstd[m0 + 2]); gates[(size_t)(m0 + 3) * 24 + j] = sigmoidf_(a3 * rstd[m0 + 3]);
}

__global__ void __launch_bounds__(256) k_qknorm(bf16_t* __restrict__ Z, const float* __restrict__ qn, const float* __restrict__ kn  ) {
    const int m = blockIdx.x * 4 + (threadIdx.x >> 6), lane = threadIdx.x & 63, sub = lane >> 4, e = (lane & 15) * 4;
#pragma unroll
    for (int p = 0; p < 3; ++p) {
        const int v = p * 4 + sub;
        const int col = v < 8 ? v * 64 : (v < 10 ? ZKV + 2 * 128 + (v - 8) * 64 : ZKV + 4 * 128 + (v - 10) * 64);
        const float* gm = v < 8 ? qn : (v < 10 ? kn + 64 : kn + 128);
        const float sc = v < 8 ? 0.125f : 1.f;
        uint2* ptr = (uint2*)(Z + (size_t)m * NZ + col + e);
        const uint2 w = *ptr;
        const float a = bf2f(w.x & 0xffff), b = bf2f(w.x >> 16), c = bf2f(w.y & 0xffff), d = bf2f(w.y >> 16);
        float s = a * a + b * b + c * c + d * d;
        s += __shfl_xor(s, 1); s += __shfl_xor(s, 2); s += __shfl_xor(s, 4); s += __shfl_xor(s, 8);
        const float r = rsqrtf(s * (1.f / 64.f) + 1e-6f) * sc;
        uint2 o; o.x = f2bf(a * r * gm[e]) | (f2bf(b * r * gm[e + 1]) << 16); o.y = f2bf(c * r * gm[e + 2]) | (f2bf(d * r * gm[e + 3]) << 16);
        *ptr = o;
    }
}

__global__ void __launch_bounds__(128) k_compress(const bf16_t* __restrict__ Z, const float* __restrict__ pos  , const float* __restrict__ w1  ,
                                                  const float* __restrict__ w2  , const float* __restrict__ kn0  , float* __restrict__ KC, float* __restrict__ VC) {
    __shared__ float zs[144][64];
    __shared__ float hid[8][128];
    const int kv = blockIdx.y, bh = blockIdx.x >> 7, ig = blockIdx.x & 127, b = bh >> 1, h = bh & 1, i0 = ig * 8, tid = threadIdx.x;
    const int col = ZKV + kv * 128 + h * 64;
    for (int e = tid; e < 144 * 64; e += 128) { const int tt = e >> 6, d = e & 63; const int tok = 16 * i0 + tt;
        zs[tt][d] = tok < SEQ ? bf2f(Z[(size_t)(b * SEQ + tok) * NZ + col + d]) : 0.f; }
    __syncthreads();
    const float* W1 = w1 + (size_t)kv * 2048 * 128; const float* P = pos + kv * 2048;
    float acc[8]; float cb = 0.f;
#pragma unroll
    for (int r = 0; r < 8; ++r) acc[r] = 0.f;
    for (int l = 0; l < 32; ++l)
        for (int d = 0; d < 64; ++d) { const float w = W1[(size_t)(l * 64 + d) * 128 + tid]; cb += P[l * 64 + d] * w;
#pragma unroll
            for (int r = 0; r < 8; ++r) acc[r] += zs[16 * r + l][d] * w; }
#pragma unroll
    for (int r = 0; r < 8; ++r) hid[r][tid] = gelu_tanh(acc[r] + cb);
    __syncthreads();
    const int c = tid & 63, half = tid >> 6; const float* W2 = w2 + kv * 128 * 64;
    float o[4] = {0.f, 0.f, 0.f, 0.f};
    for (int j = 0; j < 128; ++j) { const float w = W2[j * 64 + c];
#pragma unroll
        for (int r = 0; r < 4; ++r) o[r] += hid[half * 4 + r][j] * w; }
#pragma unroll
    for (int r = 0; r < 4; ++r) { const int i = i0 + half * 4 + r; float val = o[r];
        if (kv == 0) { const float ss = wave_sum(val * val); val = val * rsqrtf(ss * (1.f / 64.f) + 1e-6f) * kn0[c]; }
        if (i < NC) { float* dst = (kv == 0 ? KC : VC) + ((size_t)bh * 1024 + i) * 64 + c; *dst = val; } }
}

__global__ void __launch_bounds__(256) k_lru1(const bf16_t* __restrict__ Z, const float* __restrict__ cw  , const float* __restrict__ cbias, const float* __restrict__ wa  ,
                                               const float* __restrict__ ba, const float* __restrict__ wx, const float* __restrict__ bx, const float* __restrict__ lam,
                                               float* __restrict__ Hloc, float* __restrict__ Pc, float* __restrict__ SP, float* __restrict__ SH) {
    __shared__ float xs[32][256];
    const int c = threadIdx.x, chunk = blockIdx.x & 511, b = blockIdx.x >> 9, t0 = chunk * 32;
    const float w0 = cw[c], w1 = cw[256 + c], w2 = cw[512 + c], w3 = cw[768 + c], bb = cbias[c];
    const bf16_t* zx = Z + (size_t)(b * SEQ) * NZ + ZLX + c;
    float xm3 = t0 >= 3 ? bf2f(zx[(size_t)(t0 - 3) * NZ]) : 0.f, xm2 = t0 >= 2 ? bf2f(zx[(size_t)(t0 - 2) * NZ]) : 0.f, xm1 = t0 >= 1 ? bf2f(zx[(size_t)(t0 - 1) * NZ]) : 0.f;
    for (int tt = 0; tt < 32; ++tt) { const float x0 = bf2f(zx[(size_t)(t0 + tt) * NZ]);
        xs[tt][c] = bb + w0 * xm3 + w1 * xm2 + w2 * xm1 + w3 * x0; xm3 = xm2; xm2 = xm1; xm1 = x0; }
    __syncthreads();
    const int hh = c >> 5, j = c & 31;
    float war[32], wxr[32];
#pragma unroll
    for (int i = 0; i < 32; ++i) { war[i] = wa[(hh * 32 + i) * 32 + j]; wxr[i] = wx[(hh * 32 + i) * 32 + j]; }
    const float bac = ba[c], bxc = bx[c]; const float sp = log1pf(expf(-lam[c]));
    float hst = 0.f, pr = 1.f;
    for (int tt = 0; tt < 32; ++tt) {
        float ra = 0.f, rx = 0.f;
#pragma unroll
        for (int i = 0; i < 32; ++i) { const float xv = xs[tt][hh * 32 + i]; ra += xv * war[i]; rx += xv * wxr[i]; }
        const float r = sigmoidf_(ra + bac), ig = sigmoidf_(rx + bxc);
        const float log_a = -8.f * r * sp, a = expf(log_a), mult = sqrtf(-expm1f(2.f * log_a));
        const float u = xs[tt][c] * ig * mult;
        hst = a * hst + u; pr *= a;
        const size_t o = (size_t)(b * SEQ + t0 + tt) * 256 + c; Hloc[o] = hst; Pc[o] = pr; }
    SP[(size_t)(b * 512 + chunk) * 256 + c] = pr; SH[(size_t)(b * 512 + chunk) * 256 + c] = hst;
}
__global__ void __launch_bounds__(256) k_lru2(const float* __restrict__ SP, const float* __restrict__ SH, float* __restrict__ CIN) {
    const int c = threadIdx.x, b = blockIdx.x; float run = 0.f;
    for (int ch = 0; ch < 512; ++ch) { const size_t o = (size_t)(b * 512 + ch) * 256 + c; CIN[o] = run; run = SP[o] * run + SH[o]; }
}

__global__ void __launch_bounds__(256) k_conv(const bf16_t* __restrict__ Z, const float* __restrict__ dw  , const float* __restrict__ dwb, const float* __restrict__ lng, const float* __restrict__ lnb,
                                               float* __restrict__ YCV) {
    __shared__ float gl[46][256];
    __shared__ float red[16][4];
    const int c = threadIdx.x, chunk = blockIdx.x & 1023, b = blockIdx.x >> 10, t0 = chunk * 16, wv = c >> 6;
    for (int tt = 0; tt < 46; ++tt) { const int t = t0 - 30 + tt; float v = 0.f;
        if (t >= 0) { const bf16_t* zr = Z + (size_t)(b * SEQ + t) * NZ + ZCV; v = bf2f(zr[c]) * sigmoidf_(bf2f(zr[256 + c])); }
        gl[tt][c] = v; }
    __syncthreads();
    float y[16]; const float bias = dwb[c];
#pragma unroll
    for (int tt = 0; tt < 16; ++tt) y[tt] = bias;
    for (int k = 0; k < 31; ++k) { const float w = dw[k * 256 + c];
#pragma unroll
        for (int tt = 0; tt < 16; ++tt) y[tt] += w * gl[tt + k][c]; }
#pragma unroll
    for (int tt = 0; tt < 16; ++tt) { const float s = wave_sum(y[tt]); if ((c & 63) == 0) red[tt][wv] = s; }
    __syncthreads();
    float mu[16];
#pragma unroll
    for (int tt = 0; tt < 16; ++tt) mu[tt] = (red[tt][0] + red[tt][1] + red[tt][2] + red[tt][3]) * (1.f / 256.f);
    __syncthreads();
#pragma unroll
    for (int tt = 0; tt < 16; ++tt) { const float d = y[tt] - mu[tt]; const float s = wave_sum(d * d); if ((c & 63) == 0) red[tt][wv] = s; }
    __syncthreads();
    const float g = lng[c], bt = lnb[c];
#pragma unroll
    for (int tt = 0; tt < 16; ++tt) { const float var = (red[tt][0] + red[tt][1] + red[tt][2] + red[tt][3]) * (1.f / 256.f);
        const float v = (y[tt] - mu[tt]) * rsqrtf(var + 1e-6f) * g + bt;
        YCV[(size_t)(b * SEQ + t0 + tt) * 256 + c] = v * sigmoidf_(v); }
}

__global__ void __launch_bounds__(256) k_groupnorm(const float* __restrict__ YATT, const float* __restrict__ Hloc, const float* __restrict__ Pc, const float* __restrict__ CIN, const bf16_t* __restrict__ Z,
                                                    const float* __restrict__ YCV, const float* __restrict__ gout, bf16_t* __restrict__ Y) {
    const int m = blockIdx.x * 4 + (threadIdx.x >> 6), lane = threadIdx.x & 63, b = m / SEQ, t = m % SEQ;
    const float4* ya = (const float4*)(YATT + (size_t)m * 512) + lane * 2;
    const float4 a0 = ya[0], a1 = ya[1];
    float s = (a0.x * a0.x + a0.y * a0.y) + (a0.z * a0.z + a0.w * a0.w) + (a1.x * a1.x + a1.y * a1.y) + (a1.z * a1.z + a1.w * a1.w);
    const float ra = rsqrtf(wave_sum(s) * (1.f / 512.f) + 1e-6f);
    { const float* g = gout + lane * 8; uint4 w;
      w.x = f2bf(a0.x * ra * g[0]) | (f2bf(a0.y * ra * g[1]) << 16); w.y = f2bf(a0.z * ra * g[2]) | (f2bf(a0.w * ra * g[3]) << 16);
      w.z = f2bf(a1.x * ra * g[4]) | (f2bf(a1.y * ra * g[5]) << 16); w.w = f2bf(a1.z * ra * g[6]) | (f2bf(a1.w * ra * g[7]) << 16);
      *((uint4*)(Y + (size_t)m * 1024) + lane) = w; }
    { const int c0 = lane * 4; const size_t o = (size_t)m * 256 + c0; const float4 hl = *(const float4*)(Hloc + o), pc = *(const float4*)(Pc + o);
      const float4 ci = *(const float4*)(CIN + (size_t)(b * 512 + (t >> 5)) * 256 + c0);
      const uint2 gz = *(const uint2*)(Z + (size_t)m * NZ + ZLG + c0);
      float y0 = (hl.x + pc.x * ci.x) * gelu_tanh(bf2f(gz.x & 0xffff)), y1 = (hl.y + pc.y * ci.y) * gelu_tanh(bf2f(gz.x >> 16));
      float y2 = (hl.z + pc.z * ci.z) * gelu_tanh(bf2f(gz.y & 0xffff)), y3 = (hl.w + pc.w * ci.w) * gelu_tanh(bf2f(gz.y >> 16));
      const float rl = rsqrtf(wave_sum(y0 * y0 + y1 * y1 + y2 * y2 + y3 * y3) * (1.f / 256.f) + 1e-6f);
      const float* g = gout + 512 + c0; uint2 w; w.x = f2bf(y0 * rl * g[0]) | (f2bf(y1 * rl * g[1]) << 16); w.y = f2bf(y2 * rl * g[2]) | (f2bf(y3 * rl * g[3]) << 16);
      *((uint2*)(Y + (size_t)m * 1024 + 512) + lane) = w; }
    { const int c0 = lane * 4; const float4 v = *(const float4*)(YCV + (size_t)m * 256 + c0);
      const float rc = rsqrtf(wave_sum(v.x * v.x + v.y * v.y + v.z * v.z + v.w * v.w) * (1.f / 256.f) + 1e-6f);
      const float* g = gout + 768 + c0; uint2 w; w.x = f2bf(v.x * rc * g[0]) | (f2bf(v.y * rc * g[1]) << 16); w.y = f2bf(v.z * rc * g[2]) | (f2bf(v.w * rc * g[3]) << 16);
      *((uint2*)(Y + (size_t)m * 1024 + 768) + lane) = w; }
}

constexpr int ATT_LDS = (64 * 64 * 2 + 64 * 257 + 64 * 8) * 4;
__device__ __forceinline__ float dot64(const float (&q)[64], const float* kr) {
    float s0 = 0.f, s1 = 0.f, s2 = 0.f, s3 = 0.f;
#pragma unroll
    for (int d = 0; d < 64; d += 4) { const float4 k = *(const float4*)(kr + d); s0 += q[d] * k.x; s1 += q[d + 1] * k.y; s2 += q[d + 2] * k.z; s3 += q[d + 3] * k.w; }
    return (s0 + s1) + (s2 + s3);
}
__device__ __forceinline__ void axpy64(float (&a)[64], float p, const float* vr) {
#pragma unroll
    for (int d = 0; d < 64; d += 4) { const float4 v = *(const float4*)(vr + d); a[d] += p * v.x; a[d + 1] += p * v.y; a[d + 2] += p * v.z; a[d + 3] += p * v.w; }
}
__global__ void __launch_bounds__(256) k_attn_naive(const bf16_t* __restrict__ Z, const float* __restrict__ KC, const float* __restrict__ VC, const float* __restrict__ gates, float* __restrict__ YATT) {
    extern __shared__ __attribute__((aligned(16))) float sm[];
    float* Ks = sm; float* Vs = sm + 4096; float* imp = sm + 8192; unsigned* sel = (unsigned*)(sm + 8192 + 64 * 257);
    const int item = blockIdx.x, tile = 255 - (item & 255), bh = item >> 8, b = bh >> 1, h = bh & 1;
    const int tid = threadIdx.x, lane = tid & 63, wv = tid >> 6, g = lane & 3, tq = wv * 16 + (lane >> 2);
    const int t0 = tile * 64, t = t0 + tq, cur = tile, hq = h * 4 + g;
    const size_t m = (size_t)b * SEQ + t;
    float q[64], acc[64], o[64];
    { const uint4* qp = (const uint4*)(Z + m * NZ + hq * 64);
#pragma unroll
      for (int i = 0; i < 8; ++i) { const uint4 w = qp[i];
          q[8 * i + 0] = bf2f(w.x & 0xffff); q[8 * i + 1] = bf2f(w.x >> 16); q[8 * i + 2] = bf2f(w.y & 0xffff); q[8 * i + 3] = bf2f(w.y >> 16);
          q[8 * i + 4] = bf2f(w.z & 0xffff); q[8 * i + 5] = bf2f(w.z >> 16); q[8 * i + 6] = bf2f(w.w & 0xffff); q[8 * i + 7] = bf2f(w.w >> 16); } }
    const float gc = gates[m * 24 + hq * 3 + 0], gs = gates[m * 24 + hq * 3 + 1], gw = gates[m * 24 + hq * 3 + 2];
    for (int e = tid; e < 64 * 257; e += 256) imp[e] = 0.f;
    for (int e = tid; e < 64 * 8; e += 256) sel[e] = 0u;
    const int nk = min(NC, t0 / 16 + 3);
    const float* kcb = KC + (size_t)bh * 1024 * 64; const float* vcb = VC + (size_t)bh * 1024 * 64;
    float l = 0.f;
    for (int n0 = 0; n0 < nk; n0 += 64) {
        __syncthreads();
        for (int e = tid; e < 1024; e += 256) { const int kk = e >> 4, d4 = (e & 15) * 4; const int n = n0 + kk;
            *(float4*)(Ks + kk * 64 + d4) = n < nk ? *(const float4*)(kcb + (size_t)n * 64 + d4) : make_float4(0.f, 0.f, 0.f, 0.f); }
        __syncthreads();
        const int kend = min(64, nk - n0);
        for (int kk = 0; kk < kend; ++kk) { const int n = n0 + kk; const float s = dot64(q, Ks + kk * 64); if (16 * n + 31 <= t) l += __expf(s); }
    }
    const float inv_l = l > 0.f ? 1.f / l : 0.f;
#pragma unroll
    for (int d = 0; d < 64; ++d) acc[d] = 0.f;
    for (int n0 = 0; n0 < nk; n0 += 64) {
        __syncthreads();
        for (int e = tid; e < 1024; e += 256) { const int kk = e >> 4, d4 = (e & 15) * 4; const int n = n0 + kk;
            *(float4*)(Ks + kk * 64 + d4) = n < nk ? *(const float4*)(kcb + (size_t)n * 64 + d4) : make_float4(0.f, 0.f, 0.f, 0.f);
            *(float4*)(Vs + kk * 64 + d4) = n < nk ? *(const float4*)(vcb + (size_t)n * 64 + d4) : make_float4(0.f, 0.f, 0.f, 0.f); }
        __syncthreads();
        const int kend = min(64, nk - n0);
        for (int kk = 0; kk < kend; ++kk) { const int n = n0 + kk; const float s = dot64(q, Ks + kk * 64);
            const float p = (16 * n + 31 <= t) ? __expf(s) * inv_l : 0.f;
            axpy64(acc, p, Vs + kk * 64);
            float ps = p + __shfl_xor(p, 1); ps += __shfl_xor(ps, 2);
            if (g == 0) { imp[tq * 257 + (n >> 2)] += ps; if ((n & 3) == 3) imp[tq * 257 + (n >> 2) + 1] += ps; } }
    }
#pragma unroll
    for (int d = 0; d < 64; ++d) o[d] = gc * acc[d];
    __syncthreads();
    if (cur + 1 <= 16) { if (g == 0) sel[tq * 8] = (cur + 1 >= 32) ? 0xffffffffu : ((1u << (cur + 1)) - 1u); }
    else {
        if (g == 0) { sel[tq * 8] |= 1u; sel[tq * 8 + (cur >> 5)] |= 1u << (cur & 31); sel[tq * 8 + ((cur - 1) >> 5)] |= 1u << ((cur - 1) & 31); }
        for (int it = 0; it < 13; ++it) {
            __syncthreads();
            float best = -1.f; int bj = 0x7fffffff;
            for (int j = 1 + g; j <= cur - 2; j += 4) { const float v = imp[tq * 257 + j]; if (v > best) { best = v; bj = j; } }
#pragma unroll
            for (int off = 1; off <= 2; off <<= 1) { const float ob = __shfl_xor(best, off); const int oj = __shfl_xor(bj, off); if (ob > best || (ob == best && oj < bj)) { best = ob; bj = oj; } }
            if (g == 0 && bj <= cur - 2) { imp[tq * 257 + bj] = -2.f; sel[tq * 8 + (bj >> 5)] |= 1u << (bj & 31); }
        }
    }
    __syncthreads();
    const bf16_t* zb = Z + (size_t)b * SEQ * NZ;
    {
        float ls = 0.f;
#pragma unroll
        for (int d = 0; d < 64; ++d) acc[d] = 0.f;
        for (int j = 0; j <= cur; ++j) {
            __syncthreads();
            for (int e = tid; e < 512; e += 256) { const int kk = e >> 3, c8 = (e & 7) * 8; const bf16_t* rp = zb + (size_t)(64 * j + kk) * NZ + ZKV + h * 64 + c8;
                const uint4 kw = *(const uint4*)(rp + 2 * 128), vw = *(const uint4*)(rp + 3 * 128);
                float* kd = Ks + kk * 64 + c8; float* vd = Vs + kk * 64 + c8;
                kd[0] = bf2f(kw.x & 0xffff); kd[1] = bf2f(kw.x >> 16); kd[2] = bf2f(kw.y & 0xffff); kd[3] = bf2f(kw.y >> 16); kd[4] = bf2f(kw.z & 0xffff); kd[5] = bf2f(kw.z >> 16); kd[6] = bf2f(kw.w & 0xffff); kd[7] = bf2f(kw.w >> 16);
                vd[0] = bf2f(vw.x & 0xffff); vd[1] = bf2f(vw.x >> 16); vd[2] = bf2f(vw.y & 0xffff); vd[3] = bf2f(vw.y >> 16); vd[4] = bf2f(vw.z & 0xffff); vd[5] = bf2f(vw.z >> 16); vd[6] = bf2f(vw.w & 0xffff); vd[7] = bf2f(vw.w >> 16); }
            __syncthreads();
            const bool mine = (sel[tq * 8 + (j >> 5)] >> (j & 31)) & 1u;
            if (mine) for (int kk = 0; kk < 64; ++kk) { if (64 * j + kk <= t) { const float p = __expf(dot64(q, Ks + kk * 64)); ls += p; axpy64(acc, p, Vs + kk * 64); } }
        }
        const float sc = gs / ls;
#pragma unroll
        for (int d = 0; d < 64; ++d) o[d] += sc * acc[d];
    }
    {
        float lw = 0.f;
#pragma unroll
        for (int d = 0; d < 64; ++d) acc[d] = 0.f;
        for (int j = max(0, cur - 8); j <= cur; ++j) {
            __syncthreads();
            for (int e = tid; e < 512; e += 256) { const int kk = e >> 3, c8 = (e & 7) * 8; const bf16_t* rp = zb + (size_t)(64 * j + kk) * NZ + ZKV + h * 64 + c8;
                const uint4 kw = *(const uint4*)(rp + 4 * 128), vw = *(const uint4*)(rp + 5 * 128);
                float* kd = Ks + kk * 64 + c8; float* vd = Vs + kk * 64 + c8;
                kd[0] = bf2f(kw.x & 0xffff); kd[1] = bf2f(kw.x >> 16); kd[2] = bf2f(kw.y & 0xffff); kd[3] = bf2f(kw.y >> 16); kd[4] = bf2f(kw.z & 0xffff); kd[5] = bf2f(kw.z >> 16); kd[6] = bf2f(kw.w & 0xffff); kd[7] = bf2f(kw.w >> 16);
                vd[0] = bf2f(vw.x & 0xffff); vd[1] = bf2f(vw.x >> 16); vd[2] = bf2f(vw.y & 0xffff); vd[3] = bf2f(vw.y >> 16); vd[4] = bf2f(vw.z & 0xffff); vd[5] = bf2f(vw.z >> 16); vd[6] = bf2f(vw.w & 0xffff); vd[7] = bf2f(vw.w >> 16); }
            __syncthreads();
            for (int kk = 0; kk < 64; ++kk) { const int kp = 64 * j + kk; if (kp <= t && kp > t - 512) { const float p = __expf(dot64(q, Ks + kk * 64)); lw += p; axpy64(acc, p, Vs + kk * 64); } }
        }
        const float sc = gw / lw;
#pragma unroll
        for (int d = 0; d < 64; ++d) o[d] += sc * acc[d];
    }
    float4* op = (float4*)(YATT + m * 512 + hq * 64);
#pragma unroll
    for (int i = 0; i < 16; ++i) op[i] = make_float4(o[4 * i], o[4 * i + 1], o[4 * i + 2], o[4 * i + 3]);
}

constexpr size_t MiB = 1u << 20;
constexpr size_t WS_WIN = 1 * MiB;
constexpr size_t WS_WOUT = 11 * MiB;
constexpr size_t WS_W1 = 15 * MiB;
constexpr size_t WS_W2 = 31 * MiB;
constexpr size_t WS_RSTD = 47 * MiB;
constexpr size_t WS_LRUS = 48 * MiB;
constexpr size_t WS_XN = 65 * MiB;
constexpr size_t WS_Z = 129 * MiB;
constexpr size_t WS_GATES = 273 * MiB;
constexpr size_t WS_KC = 276 * MiB, WS_VC = 277 * MiB;
constexpr size_t WS_YATT = 278 * MiB;
constexpr size_t WS_HLOC = 342 * MiB;
constexpr size_t WS_YCV = 374 * MiB;
constexpr size_t WS_Y = 406 * MiB;
constexpr size_t WS_PC = 470 * MiB;
constexpr size_t WS_H = 129 * MiB;
constexpr size_t WS_END = 502 * MiB;

extern "C" void kernel_launch(void* const* d_in, const int* in_sizes, int n_in, void* d_out, int out_size, void* d_ws, size_t ws_size, hipStream_t stream) {
    if (n_in != 24 || in_sizes[0] != MTOK * D_MODEL || out_size != MTOK * D_MODEL || ws_size < WS_END) {
        fprintf(stderr, "kernel_launch: unexpected shapes: n_in %d in0 %d out %d ws %zu (need %zu)\n", n_in, n_in > 0 ? in_sizes[0] : -1, out_size, ws_size, (size_t)WS_END); return; }
    const float* x = (const float*)d_in[0]; const float* attn_norm = (const float*)d_in[1]; const float* w_in = (const float*)d_in[2]; const float* q_norm = (const float*)d_in[3];
    const float* k_norm = (const float*)d_in[4]; const float* cmp_pos = (const float*)d_in[5]; const float* cmp_w1 = (const float*)d_in[6]; const float* cmp_w2 = (const float*)d_in[7];
    const float* lru_conv_w = (const float*)d_in[8]; const float* lru_conv_b = (const float*)d_in[9]; const float* lru_wa = (const float*)d_in[10]; const float* lru_ba = (const float*)d_in[11];
    const float* lru_wx = (const float*)d_in[12]; const float* lru_bx = (const float*)d_in[13]; const float* lru_lambda = (const float*)d_in[14]; const float* cv_dw_w = (const float*)d_in[15];
    const float* cv_dw_b = (const float*)d_in[16]; const float* cv_ln_g = (const float*)d_in[17]; const float* cv_ln_b = (const float*)d_in[18]; const float* out_norm = (const float*)d_in[19];
    const float* w_out = (const float*)d_in[20]; const float* mlp_norm = (const float*)d_in[21]; const float* mlp_w1 = (const float*)d_in[22]; const float* mlp_w2 = (const float*)d_in[23];
    unsigned char* ws = (unsigned char*)d_ws; float* out = (float*)d_out;
    bf16_t* WinT = (bf16_t*)(ws + WS_WIN); bf16_t* WoutT = (bf16_t*)(ws + WS_WOUT); bf16_t* W1T = (bf16_t*)(ws + WS_W1); bf16_t* W2T = (bf16_t*)(ws + WS_W2);
    float* rstd = (float*)(ws + WS_RSTD); float* SP = (float*)(ws + WS_LRUS); float* SH = SP + 2 * 512 * 256; float* CIN = SH + 2 * 512 * 256;
    bf16_t* XN = (bf16_t*)(ws + WS_XN); bf16_t* Z = (bf16_t*)(ws + WS_Z); float* gates = (float*)(ws + WS_GATES); float* KC = (float*)(ws + WS_KC); float* VC = (float*)(ws + WS_VC);
    float* YATT = (float*)(ws + WS_YATT); float* HLOC = (float*)(ws + WS_HLOC); float* YCV = (float*)(ws + WS_YCV); bf16_t* Y = (bf16_t*)(ws + WS_Y); float* PC = (float*)(ws + WS_PC); bf16_t* H = (bf16_t*)(ws + WS_H);

    static bool attr_done = false;
    if (!attr_done) {
        (void)hipFuncSetAttribute((const void*)k_gemm<pg8::EpiBf16<0>>, hipFuncAttributeMaxDynamicSharedMemorySize, pg8::STAGE_BYTES);
        (void)hipFuncSetAttribute((const void*)k_gemm<pg8::EpiBf16<2>>, hipFuncAttributeMaxDynamicSharedMemorySize, pg8::STAGE_BYTES);
        (void)hipFuncSetAttribute((const void*)k_gemm<pg8::EpiResF32>, hipFuncAttributeMaxDynamicSharedMemorySize, pg8::STAGE_BYTES);
        (void)hipFuncSetAttribute((const void*)k_attn_naive, hipFuncAttributeMaxDynamicSharedMemorySize, ATT_LDS);
        attr_done = true;
    }
    for (int l = 0; l < 2; ++l) {
        const float* wi = w_in + (size_t)l * D_MODEL * N_IN;
        k_transpose<<<dim3(1280 / 32, 1024 / 32), 256, 0, stream>>>(wi, 1024, N_IN, 0, WinT + (size_t)l * NZ * 1024, 0);
        k_transpose<<<dim3(1024 / 32, 1024 / 32), 256, 0, stream>>>(wi, 1024, N_IN, OFF_LRU_SRC, WinT + (size_t)l * NZ * 1024, 1280);
        k_transpose<<<dim3(1024 / 32, 1024 / 32), 256, 0, stream>>>(w_out + (size_t)l * 1024 * 1024, 1024, 1024, 0, WoutT + (size_t)l * 1024 * 1024, 0);
        k_transpose<<<dim3(4096 / 32, 1024 / 32), 256, 0, stream>>>(mlp_w1 + (size_t)l * 1024 * 4096, 1024, 4096, 0, W1T + (size_t)l * 4096 * 1024, 0);
        k_transpose<<<dim3(1024 / 32, 4096 / 32), 256, 0, stream>>>(mlp_w2 + (size_t)l * 4096 * 1024, 4096, 1024, 0, W2T + (size_t)l * 1024 * 4096, 0);
    }
    const int G = 256;
    for (int l = 0; l < 2; ++l) {
        const float* xin = l == 0 ? x : out;
        k_rmsnorm<<<MTOK / 4, 256, 0, stream>>>(xin, attn_norm + l * 1024, XN, rstd);
        k_gates<<<MTOK / 32, 192, 0, stream>>>(xin, attn_norm + l * 1024, w_in + (size_t)l * D_MODEL * N_IN, rstd, gates);
        { pg8::Gemm g{XN, WinT + (size_t)l * NZ * 1024, MTOK, NZ, 1024}; pg8::EpiBf16<0> E{Z, NZ}; k_gemm<<<G, 512, pg8::STAGE_BYTES, stream>>>(g, E); }
        k_qknorm<<<MTOK / 4, 256, 0, stream>>>(Z, q_norm + l * 64, k_norm + l * 192);
        k_compress<<<dim3(512, 2), 128, 0, stream>>>(Z, cmp_pos + (size_t)l * 2 * 2048, cmp_w1 + (size_t)l * 2 * 2048 * 128, cmp_w2 + (size_t)l * 2 * 128 * 64, k_norm + l * 192, KC, VC);
        k_lru1<<<1024, 256, 0, stream>>>(Z, lru_conv_w + l * 1024, lru_conv_b + l * 256, lru_wa + l * 8192, lru_ba + l * 256, lru_wx + l * 8192, lru_bx + l * 256, lru_lambda + l * 256, HLOC, PC, SP, SH);
        k_lru2<<<2, 256, 0, stream>>>(SP, SH, CIN);
        k_conv<<<2048, 256, 0, stream>>>(Z, cv_dw_w + l * 31 * 256, cv_dw_b + l * 256, cv_ln_g + l * 256, cv_ln_b + l * 256, YCV);
        k_attn_naive<<<1024, 256, ATT_LDS, stream>>>(Z, KC, VC, gates, YATT);
        k_groupnorm<<<MTOK / 4, 256, 0, stream>>>(YATT, HLOC, PC, CIN, Z, YCV, out_norm + l * 1024, Y);
        { pg8::Gemm g{Y, WoutT + (size_t)l * 1024 * 1024, MTOK, 1024, 1024}; pg8::EpiResF32 E{xin, out, 1024}; k_gemm<<<G, 512, pg8::STAGE_BYTES, stream>>>(g, E); }
        k_rmsnorm<<<MTOK / 4, 256, 0, stream>>>(out, mlp_norm + l * 1024, XN, rstd);
        { pg8::Gemm g{XN, W1T + (size_t)l * 4096 * 1024, MTOK, 4096, 1024}; pg8::EpiBf16<2> E{H, 4096}; k_gemm<<<G, 512, pg8::STAGE_BYTES, stream>>>(g, E); }
        { pg8::Gemm g{H, W2T + (size_t)l * 1024 * 4096, MTOK, 1024, 4096}; pg8::EpiResF32 E{out, out, 1024}; k_gemm<<<G, 512, pg8::STAGE_BYTES, stream>>>(g, E); }
    }
}
```

```cpp
#include <hip/hip_runtime.h>
#include <cstdio>
#include <cstdint>

constexpr int D_MODEL = 1024, BATCH = 2, SEQ = 16384, MTOK = BATCH * SEQ, N_IN = 2328, NZ = 2304, D_FF = 4096;
constexpr int ZQ = 0, ZKV = 512, ZLX = 1280, ZLG = 1536, ZCV = 1792;
constexpr int OFF_GATE_SRC = 1280, OFF_LRU_SRC = 1304;
constexpr int NC = 1023, NSLC = 256;

typedef unsigned short bf16_t;
__device__ __forceinline__ unsigned f2bf(float f) { unsigned u = __builtin_bit_cast(unsigned, f); return (u + 0x7fffu + ((u >> 16) & 1u)) >> 16; }
__device__ __forceinline__ float bf2f(unsigned short h) { return __builtin_bit_cast(float, (unsigned)h << 16); }
__device__ __forceinline__ float wave_sum(float v) {
#pragma unroll
    for (int o = 1; o < 64; o <<= 1) v += __shfl_xor(v, o);
    return v;
}
__device__ __forceinline__ float gelu_tanh(float x) { const float u = 0.7978845608028654f * (x + 0.044715f * x * x * x); return 0.5f * x * (1.f + tanhf(u)); }
__device__ __forceinline__ float sigmoidf_(float x) { return 1.f / (1.f + __expf(-x)); }

namespace pg8 {
#define PG8_LAS __attribute__((address_space(3)))
using ::bf16_t;
typedef short bf16x8 __attribute__((ext_vector_type(8)));
typedef float f32x4 __attribute__((ext_vector_type(4)));
typedef unsigned u32x4 __attribute__((ext_vector_type(4)));
constexpr int BM = 256, BK = 64, HALF = 128, HTB = HALF * BK * 2  , STAGE_BYTES = 8 * HTB, NXCD = 8, WGM = 8;

__host__ __device__ __forceinline__ int lds_byte(int r, int c) { const int st = (r >> 4) * 2 + (c >> 5), rr = r & 15, cc = c & 31, ob = rr * 64 + cc * 2; return st * 1024 + (ob ^ (((ob >> 9) & 1) << 5)); }
__host__ __device__ __forceinline__ void stage_rc(int b, int& R, int& C) { const int st = b / 1024, sb = b % 1024, swz = sb ^ (((sb >> 9) & 1) << 5); R = (st >> 1) * 16 + swz / 64; C = (st & 1) * 32 + (swz % 64) / 2; }
__host__ __device__ __forceinline__ int perm32(int rho) { const int n = rho >> 4, i = rho & 15; return 8 * (i >> 2) + 4 * n + (i & 3); }

struct Unit { int pm, pn; };
struct Gemm { const bf16_t* A; const bf16_t* Bt; int M, N, K, pad; };

struct StaticOrder {
    int nM, nN, nwg, G, c;
    __host__ __device__ void init(int M, int N, int G_, int c_) { nM = M / BM; nN = N / BM; nwg = nM * nN; G = G_; c = c_; }
    __host__ __device__ bool next(int i, Unit& u) const {
        const long L = (long)i * G + c; if (L >= nwg) return false;
        int wgid = (int)L; { const int q = nwg / NXCD, r = nwg % NXCD, xcd = wgid % NXCD, off = wgid / NXCD; wgid = (xcd < r ? xcd * (q + 1) : r * (q + 1) + (xcd - r) * q) + off; }
        const int nig = WGM * nN, gid = wgid / nig, fm = gid * WGM, gsz = (nM - fm) < WGM ? (nM - fm) : WGM;
        u.pm = fm + ((wgid % nig) % gsz); u.pn = (wgid % nig) / gsz; return true;
    }
    __device__ __forceinline__ void a_ready(const Unit&) const {}
    __device__ __forceinline__ void done(const Unit&) const {}
};


__device__ __forceinline__ unsigned cvt_pk_bf16(float lo, float hi) { unsigned r; asm volatile("v_cvt_pk_bf16_f32 %0, %1, %2" : "=v"(r) : "v"(lo), "v"(hi)); return r; }

template <int ACT  > struct EpiBf16 {
    static constexpr bool PERM = true, AFTER_DRAIN = false;
    bf16_t* O; int ldc, pad;
    __device__ __forceinline__ void operator()(const f32x4 (&acc)[2][2][4][2], const Unit& u, int wr, int wc, int fr, int fq) const {
        const int row0 = u.pm * BM + wr * 64 + fr; const int col0 = u.pn * BM + wc * 32 + 8 * fq;
#pragma unroll
        for (int ai = 0; ai < 2; ++ai)
#pragma unroll
            for (int m = 0; m < 4; ++m) { bf16_t* rowp = O + (size_t)(row0 + ai * HALF + m * 16) * ldc + col0;
#pragma unroll
                for (int bj = 0; bj < 2; ++bj) { f32x4 v0 = acc[ai][bj][m][0], v1 = acc[ai][bj][m][1];
                    if (ACT == 2) {
#pragma unroll
                        for (int e = 0; e < 4; ++e) { float a = v0[e] > 0.f ? v0[e] : 0.f; v0[e] = a * a; float b = v1[e] > 0.f ? v1[e] : 0.f; v1[e] = b * b; } }
                    u32x4 w; w.x = cvt_pk_bf16(v0[0], v0[1]); w.y = cvt_pk_bf16(v0[2], v0[3]); w.z = cvt_pk_bf16(v1[0], v1[1]); w.w = cvt_pk_bf16(v1[2], v1[3]);
                    *(u32x4*)(rowp + bj * HALF) = w; } }
    }
};
struct EpiResF32 {
    static constexpr bool PERM = false, AFTER_DRAIN = false;
    const float* base; float* C; int ldc, pad;
    __device__ __forceinline__ void operator()(const f32x4 (&acc)[2][2][4][2], const Unit& u, int wr, int wc, int fr, int fq) const {
        const int row0 = u.pm * BM + wr * 64 + fr, col0 = u.pn * BM + wc * 32 + 4 * fq;
#pragma unroll
        for (int ai = 0; ai < 2; ++ai)
#pragma unroll
            for (int m = 0; m < 4; ++m) { const size_t off = (size_t)(row0 + ai * HALF + m * 16) * ldc + col0;
#pragma unroll
                for (int bj = 0; bj < 2; ++bj)
#pragma unroll
                    for (int n = 0; n < 2; ++n) { const f32x4 b = *(const f32x4*)(base + off + bj * HALF + n * 16); *(f32x4*)(C + off + bj * HALF + n * 16) = acc[ai][bj][m][n] + b; } }
    }
};

template <class Epi, class Sched, bool ALIGN_EPI = false, bool SP2 = false>
__device__ __forceinline__ void gemm_phase(PG8_LAS unsigned char* lds, const Gemm g, const Sched& S, const Epi& E) {
    const int tid = threadIdx.x, wid = __builtin_amdgcn_readfirstlane(tid >> 6), lane = tid & 63, wr = wid >> 2, wc = wid & 3, fr = lane & 15, fq = lane >> 4;
    const int K = g.K, nt = K / BK;
    unsigned voffA[2], voffB[2];
#pragma unroll
    for (int i = 0; i < 2; ++i) { int R, C; stage_rc(tid * 16 + i * 8192, R, C); const int Rb = Epi::PERM ? ((R & ~31) + perm32(R & 31)) : R;
        voffA[i] = (unsigned)(R * K + C) * 2u; voffB[i] = (unsigned)(Rb * K + C) * 2u; }
    const size_t kstep = (size_t)(BK * 2);
    const size_t hstep = (size_t)HALF * K * 2;
    const size_t tstep = 2 * hstep;
    const unsigned ldsw = (unsigned)wid * 1024u;
    const int aoff = lds_byte(wr * 64 + fr, fq * 8), boff = lds_byte(wc * 32 + fr, fq * 8);
#define PG8_SA(b, h) (((b) * 2 + (h)) * HTB)
#define PG8_SB(b, h) ((4 + (b) * 2 + (h)) * HTB)
#define PG8_STAGE(bufoff, gbase, voff) do { _Pragma("unroll") for (int _i = 0; _i < 2; ++_i) \
        __builtin_amdgcn_global_load_lds((const unsigned*)((const char*)(gbase) + (voff)[_i]), (PG8_LAS unsigned*)(lds + (bufoff) + ldsw + _i * 8192), 16, 0, 0); } while (0)
#define PG8_LDA(dst, b, h) do { _Pragma("unroll") for (int m = 0; m < 4; ++m) _Pragma("unroll") for (int k = 0; k < 2; ++k) dst[m][k] = *(const PG8_LAS bf16x8*)(lds + PG8_SA(b, h) + aoff + m * 2048 + k * 1024); } while (0)
#define PG8_LDB(dst, b, h) do { _Pragma("unroll") for (int n = 0; n < 2; ++n) _Pragma("unroll") for (int k = 0; k < 2; ++k) dst[n][k] = *(const PG8_LAS bf16x8*)(lds + PG8_SB(b, h) + boff + n * 2048 + k * 1024); } while (0)
#define PG8_MMA(ai, bj, At, Bt) do { __builtin_amdgcn_s_setprio(1); _Pragma("unroll") for (int m = 0; m < 4; ++m) _Pragma("unroll") for (int n = 0; n < 2; ++n) _Pragma("unroll") for (int k = 0; k < 2; ++k) \
        acc[ai][bj][m][n] = __builtin_amdgcn_mfma_f32_16x16x32_bf16(Bt[n][k], At[m][k], acc[ai][bj][m][n], 0, 0, 0); __builtin_amdgcn_s_setprio(0); } while (0)
#define PG8_WAIT_V(n) asm volatile("s_waitcnt vmcnt(" #n ")" ::: "memory")
#define PG8_WAIT_L(n) asm volatile("s_waitcnt lgkmcnt(" #n ")" ::: "memory")
#define PG8_BAR __builtin_amdgcn_s_barrier()
#define PG8_SCHED __builtin_amdgcn_sched_barrier(0)
    Unit cur, nxt; int ui = 0;
    if (!S.next(0, cur)) return;
    f32x4 acc[2][2][4][2];
#pragma unroll
    for (int a = 0; a < 2; ++a)
#pragma unroll
        for (int b = 0; b < 2; ++b)
#pragma unroll
            for (int m = 0; m < 4; ++m)
#pragma unroll
                for (int n = 0; n < 2; ++n) acc[a][b][m][n] = (f32x4){0.f, 0.f, 0.f, 0.f};
    bf16x8 At[4][2], B0[2][2], B1[2][2];
    const char* cA = (const char*)g.A + (size_t)cur.pm * tstep; const char* cB = (const char*)g.Bt + (size_t)cur.pn * tstep;
    S.a_ready(cur);
    if constexpr (SP2) {
        PG8_STAGE(PG8_SB(0, 0), cB, voffB); PG8_STAGE(PG8_SB(0, 1), cB + hstep, voffB); PG8_STAGE(PG8_SA(0, 0), cA, voffA); PG8_STAGE(PG8_SA(0, 1), cA + hstep, voffA);
        if (wr == 1) PG8_BAR;
        PG8_WAIT_V(2); PG8_BAR;
        PG8_STAGE(PG8_SB(1, 0), cB + kstep, voffB); PG8_STAGE(PG8_SA(1, 0), cA + kstep, voffA); PG8_STAGE(PG8_SB(1, 1), cB + hstep + kstep, voffB);
        PG8_WAIT_V(6); PG8_BAR;
    } else {
        PG8_STAGE(PG8_SB(0, 0), cB, voffB); PG8_STAGE(PG8_SA(0, 0), cA, voffA); PG8_STAGE(PG8_SB(0, 1), cB + hstep, voffB); PG8_STAGE(PG8_SA(0, 1), cA + hstep, voffA);
        if (wr == 1) PG8_BAR;
        PG8_WAIT_V(4); PG8_BAR;
        PG8_STAGE(PG8_SB(1, 0), cB + kstep, voffB); PG8_STAGE(PG8_SA(1, 0), cA + kstep, voffA); PG8_STAGE(PG8_SB(1, 1), cB + hstep + kstep, voffB);
        PG8_WAIT_V(6); PG8_BAR;
    }
    for (;;) {
        const bool has_next = S.next(ui + 1, nxt);
        const char* nA = has_next ? (const char*)g.A + (size_t)nxt.pm * tstep : cA; const char* nB = has_next ? (const char*)g.Bt + (size_t)nxt.pn * tstep : cB;
        for (int t = 0; t < nt; t += 2) {
            const bool last = (t == nt - 2);
            const char* a1 = cA + (size_t)(t + 1) * kstep;
            const char* a2 = last ? nA : cA + (size_t)(t + 2) * kstep; const char* b2 = last ? nB : cB + (size_t)(t + 2) * kstep;
            const char* a3 = a2 + kstep; const char* b3 = b2 + kstep;
            if (last && has_next) S.a_ready(nxt);
            if constexpr (SP2) {
            PG8_LDB(B0, 0, 0); PG8_LDB(B1, 0, 1); PG8_SCHED; PG8_LDA(At, 0, 0); PG8_STAGE(PG8_SA(1, 1), a1 + hstep, voffA);
            PG8_WAIT_V(8); PG8_WAIT_L(0); PG8_BAR; PG8_MMA(0, 0, At, B0); PG8_MMA(0, 1, At, B1); PG8_BAR; PG8_SCHED;
            PG8_LDA(At, 0, 1); PG8_STAGE(PG8_SB(0, 0), b2, voffB); PG8_STAGE(PG8_SB(0, 1), b2 + hstep, voffB); PG8_STAGE(PG8_SA(0, 0), a2, voffA);
            PG8_WAIT_V(8); PG8_WAIT_L(0); PG8_BAR; PG8_MMA(1, 0, At, B0); PG8_MMA(1, 1, At, B1); PG8_BAR; PG8_SCHED;
            PG8_LDB(B0, 1, 0); PG8_LDB(B1, 1, 1); PG8_SCHED; PG8_LDA(At, 1, 0); PG8_STAGE(PG8_SA(0, 1), a2 + hstep, voffA);
            PG8_WAIT_V(8); PG8_WAIT_L(0); PG8_BAR; PG8_MMA(0, 0, At, B0); PG8_MMA(0, 1, At, B1); PG8_BAR; PG8_SCHED;
            PG8_LDA(At, 1, 1); PG8_STAGE(PG8_SB(1, 0), b3, voffB); PG8_STAGE(PG8_SB(1, 1), b3 + hstep, voffB); PG8_STAGE(PG8_SA(1, 0), a3, voffA);
            PG8_WAIT_V(8); PG8_WAIT_L(0); PG8_BAR; PG8_MMA(1, 0, At, B0); PG8_MMA(1, 1, At, B1); PG8_BAR; PG8_SCHED;
            } else {
            PG8_LDB(B0, 0, 0); PG8_SCHED; PG8_LDA(At, 0, 0); PG8_STAGE(PG8_SA(1, 1), a1 + hstep, voffA);
            PG8_WAIT_L(8); PG8_BAR; PG8_WAIT_L(0); PG8_MMA(0, 0, At, B0); PG8_BAR; PG8_SCHED;
            PG8_LDB(B1, 0, 1); PG8_STAGE(PG8_SB(0, 0), b2, voffB);
            PG8_BAR; PG8_WAIT_L(0); PG8_MMA(0, 1, At, B1); PG8_BAR;
            PG8_LDA(At, 0, 1); PG8_STAGE(PG8_SA(0, 0), a2, voffA);
            PG8_BAR; PG8_WAIT_L(0); PG8_MMA(1, 0, At, B0); PG8_BAR; PG8_SCHED;
            PG8_STAGE(PG8_SB(0, 1), b2 + hstep, voffB);
            PG8_WAIT_V(6); PG8_BAR; PG8_MMA(1, 1, At, B1); PG8_BAR;
            PG8_LDB(B0, 1, 0); PG8_SCHED; PG8_LDA(At, 1, 0); PG8_STAGE(PG8_SA(0, 1), a2 + hstep, voffA);
            PG8_WAIT_L(8); PG8_BAR; PG8_WAIT_L(0); PG8_MMA(0, 0, At, B0); PG8_BAR; PG8_SCHED;
            PG8_LDB(B1, 1, 1); PG8_STAGE(PG8_SB(1, 0), b3, voffB);
            PG8_BAR; PG8_WAIT_L(0); PG8_MMA(0, 1, At, B1); PG8_BAR;
            PG8_LDA(At, 1, 1); PG8_STAGE(PG8_SA(1, 0), a3, voffA);
            PG8_BAR; PG8_WAIT_L(0); PG8_MMA(1, 0, At, B0); PG8_BAR; PG8_SCHED;
            PG8_STAGE(PG8_SB(1, 1), b3 + hstep, voffB);
            PG8_WAIT_V(6); PG8_BAR; PG8_MMA(1, 1, At, B1); PG8_BAR;
            }
        }
        if constexpr (ALIGN_EPI) { if (wr == 0) PG8_BAR; }
        if constexpr (!Epi::AFTER_DRAIN) { E(acc, cur, wr, wc, fr, fq); S.done(cur); }
        if (!has_next) break;
#pragma unroll
        for (int a = 0; a < 2; ++a)
#pragma unroll
            for (int b = 0; b < 2; ++b)
#pragma unroll
                for (int m = 0; m < 4; ++m)
#pragma unroll
                    for (int n = 0; n < 2; ++n) acc[a][b][m][n] = (f32x4){0.f, 0.f, 0.f, 0.f};
        cur = nxt; cA = nA; cB = nB; ++ui;
        if constexpr (ALIGN_EPI) { if (wr == 1) PG8_BAR; }
    }
    PG8_WAIT_V(0);
    if constexpr (!ALIGN_EPI) { if (wr == 0) PG8_BAR; }
    PG8_BAR;
    if constexpr (Epi::AFTER_DRAIN) { E.fused(acc, cur, wr, wc, fr, fq, lds, wid, lane); S.done(cur); }
#undef PG8_SA
#undef PG8_SB
#undef PG8_STAGE
#undef PG8_LDA
#undef PG8_LDB
#undef PG8_MMA
#undef PG8_WAIT_V
#undef PG8_WAIT_L
#undef PG8_BAR
#undef PG8_SCHED
}
}

template <class Epi>
__global__ void __launch_bounds__(512, 2) k_gemm(pg8::Gemm g, Epi E) {
    extern __shared__ __attribute__((aligned(16))) unsigned char lds_g[];
    pg8::StaticOrder S; S.init(g.M, g.N, (int)gridDim.x, (int)blockIdx.x);
    pg8::gemm_phase<Epi, pg8::StaticOrder, true, true>((PG8_LAS unsigned char*)lds_g, g, S, E);
}

__global__ void __launch_bounds__(256) k_transpose(const float* __restrict__ W, int K, int ldw, int col_off, bf16_t* __restrict__ WT, int row_off) {
    __shared__ float t[32][33];
    const int n0 = blockIdx.x * 32, k0 = blockIdx.y * 32, tx = threadIdx.x & 31, ty = threadIdx.x >> 5;
    for (int i = ty; i < 32; i += 8) t[i][tx] = W[(size_t)(k0 + i) * ldw + col_off + n0 + tx];
    __syncthreads();
    for (int i = ty; i < 32; i += 8) WT[(size_t)(row_off + n0 + i) * K + k0 + tx] = (bf16_t)f2bf(t[tx][i]);
}

__global__ void __launch_bounds__(256) k_rmsnorm(const float* __restrict__ x, const float* __restrict__ gamma, bf16_t* __restrict__ xn, float* __restrict__ rstd) {
    const int row = blockIdx.x * 4 + (threadIdx.x >> 6), lane = threadIdx.x & 63;
    const float4* xr = (const float4*)(x + (size_t)row * D_MODEL) + lane;
    float4 v[4]; float s = 0.f;
#pragma unroll
    for (int j = 0; j < 4; ++j) { v[j] = xr[64 * j]; s += (v[j].x * v[j].x + v[j].y * v[j].y) + (v[j].z * v[j].z + v[j].w * v[j].w); }
    const float r = rsqrtf(wave_sum(s) * (1.f / D_MODEL) + 1e-6f);
    if (lane == 0) rstd[row] = r;
    uint2* o = (uint2*)(xn + (size_t)row * D_MODEL) + lane;
#pragma unroll
    for (int j = 0; j < 4; ++j) { const float4 g = ((const float4*)gamma)[lane + 64 * j];
        uint2 w; w.x = f2bf(v[j].x * r * g.x) | (f2bf(v[j].y * r * g.y) << 16); w.y = f2bf(v[j].z * r * g.z) | (f2bf(v[j].w * r * g.w) << 16); o[64 * j] = w; }
}

__global__ void __launch_bounds__(192) k_gates(const float* __restrict__ x, const float* __restrict__ gamma, const float* __restrict__ w_in, const float* __restrict__ rstd, float* __restrict__ gates) {
    const int j = threadIdx.x % 24, slot = threadIdx.x / 24, m0 = blockIdx.x * 32 + slot * 4;
    float a0 = 0.f, a1 = 0.f, a2 = 0.f, a3 = 0.f;
    const float* x0 = x + (size_t)m0 * D_MODEL;
    for (int k = 0; k < D_MODEL; ++k) { const float w = w_in[(size_t)k * N_IN + OFF_GATE_SRC + j] * gamma[k];
        a0 += x0[k] * w; a1 += x0[D_MODEL + k] * w; a2 += x0[2 * D_MODEL + k] * w; a3 += x0[3 * D_MODEL + k] * w; }
    gates[(size_t)(m0 + 0) * 24 + j] = sigmoidf_(a0 * rstd[m0 + 0]); gates[(size_t)(m0 + 1) * 24 + j] = sigmoidf_(a1 * rstd[m0 + 1]);
    gates[(size_t)(m0 + 2) * 24 + j] = sigmoidf_(a2 * rstd[m0 + 2]); gates[(size_t)(m0 + 3) * 24 + j] = sigmoidf_(a3 * rstd[m0 + 3]);
}

__global__ void __launch_bounds__(256) k_qknorm(bf16_t* __restrict__ Z, const float* __restrict__ qn, const float* __restrict__ kn  ) {
    const int m = blockIdx.x * 4 + (threadIdx.x >> 6), lane = threadIdx.x & 63, sub = lane >> 4, e = (lane & 15) * 4;
#pragma unroll
    for (int p = 0; p < 3; ++p) {
        const int v = p * 4 + sub;
        const int col = v < 8 ? v * 64 : (v < 10 ? ZKV + 2 * 128 + (v - 8) * 64 : ZKV + 4 * 128 + (v - 10) * 64);
        const float* gm = v < 8 ? qn : (v < 10 ? kn + 64 : kn + 128);
        const float sc = v < 8 ? 0.125f * 1.4426950408889634f : 1.f;
        uint2* ptr = (uint2*)(Z + (size_t)m * NZ + col + e);
        const uint2 w = *ptr;
        const float a = bf2f(w.x & 0xffff), b = bf2f(w.x >> 16), c = bf2f(w.y & 0xffff), d = bf2f(w.y >> 16);
        float s = a * a + b * b + c * c + d * d;
        s += __shfl_xor(s, 1); s += __shfl_xor(s, 2); s += __shfl_xor(s, 4); s += __shfl_xor(s, 8);
        const float r = rsqrtf(s * (1.f / 64.f) + 1e-6f) * sc;
        uint2 o; o.x = f2bf(a * r * gm[e]) | (f2bf(b * r * gm[e + 1]) << 16); o.y = f2bf(c * r * gm[e + 2]) | (f2bf(d * r * gm[e + 3]) << 16);
        *ptr = o;
    }
}

__global__ void __launch_bounds__(128) k_compress(const bf16_t* __restrict__ Z, const float* __restrict__ pos  , const float* __restrict__ w1  ,
                                                  const float* __restrict__ w2  , const float* __restrict__ kn0  , bf16_t* __restrict__ KC, bf16_t* __restrict__ VC) {
    __shared__ float zs[144][64];
    __shared__ float hid[8][128];
    const int kv = blockIdx.y, bh = blockIdx.x >> 7, ig = blockIdx.x & 127, b = bh >> 1, h = bh & 1, i0 = ig * 8, tid = threadIdx.x;
    const int col = ZKV + kv * 128 + h * 64;
    for (int e = tid; e < 144 * 64; e += 128) { const int tt = e >> 6, d = e & 63; const int tok = 16 * i0 + tt;
        zs[tt][d] = tok < SEQ ? bf2f(Z[(size_t)(b * SEQ + tok) * NZ + col + d]) : 0.f; }
    __syncthreads();
    const float* W1 = w1 + (size_t)kv * 2048 * 128; const float* P = pos + kv * 2048;
    float acc[8]; float cb = 0.f;
#pragma unroll
    for (int r = 0; r < 8; ++r) acc[r] = 0.f;
    for (int l = 0; l < 32; ++l)
        for (int d = 0; d < 64; ++d) { const float w = W1[(size_t)(l * 64 + d) * 128 + tid]; cb += P[l * 64 + d] * w;
#pragma unroll
            for (int r = 0; r < 8; ++r) acc[r] += zs[16 * r + l][d] * w; }
#pragma unroll
    for (int r = 0; r < 8; ++r) hid[r][tid] = gelu_tanh(acc[r] + cb);
    __syncthreads();
    const int c = tid & 63, half = tid >> 6; const float* W2 = w2 + kv * 128 * 64;
    float o[4] = {0.f, 0.f, 0.f, 0.f};
    for (int j = 0; j < 128; ++j) { const float w = W2[j * 64 + c];
#pragma unroll
        for (int r = 0; r < 4; ++r) o[r] += hid[half * 4 + r][j] * w; }
#pragma unroll
    for (int r = 0; r < 4; ++r) { const int i = i0 + half * 4 + r; float val = o[r];
        if (kv == 0) { const float ss = wave_sum(val * val); val = val * rsqrtf(ss * (1.f / 64.f) + 1e-6f) * kn0[c]; }
        { bf16_t* dst = (kv == 0 ? KC : VC) + ((size_t)bh * 1024 + i) * 64 + c; *dst = (bf16_t)f2bf(i < NC ? val : 0.f); } }
}

__global__ void __launch_bounds__(256) k_lru1(const bf16_t* __restrict__ Z, const float* __restrict__ cw  , const float* __restrict__ cbias, const float* __restrict__ wa  ,
                                               const float* __restrict__ ba, const float* __restrict__ wx, const float* __restrict__ bx, const float* __restrict__ lam,
                                               float* __restrict__ Hloc, float* __restrict__ Pc, float* __restrict__ SP, float* __restrict__ SH) {
    __shared__ float xs[32][256];
    const int c = threadIdx.x, chunk = blockIdx.x & 511, b = blockIdx.x >> 9, t0 = chunk * 32;
    const float w0 = cw[c], w1 = cw[256 + c], w2 = cw[512 + c], w3 = cw[768 + c], bb = cbias[c];
    const bf16_t* zx = Z + (size_t)(b * SEQ) * NZ + ZLX + c;
    float xm3 = t0 >= 3 ? bf2f(zx[(size_t)(t0 - 3) * NZ]) : 0.f, xm2 = t0 >= 2 ? bf2f(zx[(size_t)(t0 - 2) * NZ]) : 0.f, xm1 = t0 >= 1 ? bf2f(zx[(size_t)(t0 - 1) * NZ]) : 0.f;
    for (int tt = 0; tt < 32; ++tt) { const float x0 = bf2f(zx[(size_t)(t0 + tt) * NZ]);
        xs[tt][c] = bb + w0 * xm3 + w1 * xm2 + w2 * xm1 + w3 * x0; xm3 = xm2; xm2 = xm1; xm1 = x0; }
    __syncthreads();
    const int hh = c >> 5, j = c & 31;
    float war[32], wxr[32];
#pragma unroll
    for (int i = 0; i < 32; ++i) { war[i] = wa[(hh * 32 + i) * 32 + j]; wxr[i] = wx[(hh * 32 + i) * 32 + j]; }
    const float bac = ba[c], bxc = bx[c]; const float sp = log1pf(expf(-lam[c]));
    float hst = 0.f, pr = 1.f;
    for (int tt = 0; tt < 32; ++tt) {
        float ra = 0.f, rx = 0.f;
#pragma unroll
        for (int i = 0; i < 32; ++i) { const float xv = xs[tt][hh * 32 + i]; ra += xv * war[i]; rx += xv * wxr[i]; }
        const float r = sigmoidf_(ra + bac), ig = sigmoidf_(rx + bxc);
        const float log_a = -8.f * r * sp, a = expf(log_a), mult = sqrtf(-expm1f(2.f * log_a));
        const float u = xs[tt][c] * ig * mult;
        hst = a * hst + u; pr *= a;
        const size_t o = (size_t)(b * SEQ + t0 + tt) * 256 + c; Hloc[o] = hst; Pc[o] = pr; }
    SP[(size_t)(b * 512 + chunk) * 256 + c] = pr; SH[(size_t)(b * 512 + chunk) * 256 + c] = hst;
}
__global__ void __launch_bounds__(256) k_lru2(const float* __restrict__ SP, const float* __restrict__ SH, float* __restrict__ CIN) {
    const int c = threadIdx.x, b = blockIdx.x; float run = 0.f;
    for (int ch = 0; ch < 512; ++ch) { const size_t o = (size_t)(b * 512 + ch) * 256 + c; CIN[o] = run; run = SP[o] * run + SH[o]; }
}

__global__ void __launch_bounds__(256) k_conv(const bf16_t* __restrict__ Z, const float* __restrict__ dw  , const float* __restrict__ dwb, const float* __restrict__ lng, const float* __restrict__ lnb,
                                               float* __restrict__ YCV) {
    __shared__ float gl[46][256];
    __shared__ float red[16][4];
    const int c = threadIdx.x, chunk = blockIdx.x & 1023, b = blockIdx.x >> 10, t0 = chunk * 16, wv = c >> 6;
    for (int tt = 0; tt < 46; ++tt) { const int t = t0 - 30 + tt; float v = 0.f;
        if (t >= 0) { const bf16_t* zr = Z + (size_t)(b * SEQ + t) * NZ + ZCV; v = bf2f(zr[c]) * sigmoidf_(bf2f(zr[256 + c])); }
        gl[tt][c] = v; }
    __syncthreads();
    float y[16]; const float bias = dwb[c];
#pragma unroll
    for (int tt = 0; tt < 16; ++tt) y[tt] = bias;
    for (int k = 0; k < 31; ++k) { const float w = dw[k * 256 + c];
#pragma unroll
        for (int tt = 0; tt < 16; ++tt) y[tt] += w * gl[tt + k][c]; }
#pragma unroll
    for (int tt = 0; tt < 16; ++tt) { const float s = wave_sum(y[tt]); if ((c & 63) == 0) red[tt][wv] = s; }
    __syncthreads();
    float mu[16];
#pragma unroll
    for (int tt = 0; tt < 16; ++tt) mu[tt] = (red[tt][0] + red[tt][1] + red[tt][2] + red[tt][3]) * (1.f / 256.f);
    __syncthreads();
#pragma unroll
    for (int tt = 0; tt < 16; ++tt) { const float d = y[tt] - mu[tt]; const float s = wave_sum(d * d); if ((c & 63) == 0) red[tt][wv] = s; }
    __syncthreads();
    const float g = lng[c], bt = lnb[c];
#pragma unroll
    for (int tt = 0; tt < 16; ++tt) { const float var = (red[tt][0] + red[tt][1] + red[tt][2] + red[tt][3]) * (1.f / 256.f);
        const float v = (y[tt] - mu[tt]) * rsqrtf(var + 1e-6f) * g + bt;
        YCV[(size_t)(b * SEQ + t0 + tt) * 256 + c] = v * sigmoidf_(v); }
}

__global__ void __launch_bounds__(256) k_groupnorm(const float* __restrict__ YATT, const float* __restrict__ Hloc, const float* __restrict__ Pc, const float* __restrict__ CIN, const bf16_t* __restrict__ Z,
                                                    const float* __restrict__ YCV, const float* __restrict__ gout, bf16_t* __restrict__ Y) {
    const int m = blockIdx.x * 4 + (threadIdx.x >> 6), lane = threadIdx.x & 63, b = m / SEQ, t = m % SEQ;
    const float4* ya = (const float4*)(YATT + (size_t)m * 512) + lane * 2;
    const float4 a0 = ya[0], a1 = ya[1];
    float s = (a0.x * a0.x + a0.y * a0.y) + (a0.z * a0.z + a0.w * a0.w) + (a1.x * a1.x + a1.y * a1.y) + (a1.z * a1.z + a1.w * a1.w);
    const float ra = rsqrtf(wave_sum(s) * (1.f / 512.f) + 1e-6f);
    { const float* g = gout + lane * 8; uint4 w;
      w.x = f2bf(a0.x * ra * g[0]) | (f2bf(a0.y * ra * g[1]) << 16); w.y = f2bf(a0.z * ra * g[2]) | (f2bf(a0.w * ra * g[3]) << 16);
      w.z = f2bf(a1.x * ra * g[4]) | (f2bf(a1.y * ra * g[5]) << 16); w.w = f2bf(a1.z * ra * g[6]) | (f2bf(a1.w * ra * g[7]) << 16);
      *((uint4*)(Y + (size_t)m * 1024) + lane) = w; }
    { const int c0 = lane * 4; const size_t o = (size_t)m * 256 + c0; const float4 hl = *(const float4*)(Hloc + o), pc = *(const float4*)(Pc + o);
      const float4 ci = *(const float4*)(CIN + (size_t)(b * 512 + (t >> 5)) * 256 + c0);
      const uint2 gz = *(const uint2*)(Z + (size_t)m * NZ + ZLG + c0);
      float y0 = (hl.x + pc.x * ci.x) * gelu_tanh(bf2f(gz.x & 0xffff)), y1 = (hl.y + pc.y * ci.y) * gelu_tanh(bf2f(gz.x >> 16));
      float y2 = (hl.z + pc.z * ci.z) * gelu_tanh(bf2f(gz.y & 0xffff)), y3 = (hl.w + pc.w * ci.w) * gelu_tanh(bf2f(gz.y >> 16));
      const float rl = rsqrtf(wave_sum(y0 * y0 + y1 * y1 + y2 * y2 + y3 * y3) * (1.f / 256.f) + 1e-6f);
      const float* g = gout + 512 + c0; uint2 w; w.x = f2bf(y0 * rl * g[0]) | (f2bf(y1 * rl * g[1]) << 16); w.y = f2bf(y2 * rl * g[2]) | (f2bf(y3 * rl * g[3]) << 16);
      *((uint2*)(Y + (size_t)m * 1024 + 512) + lane) = w; }
    { const int c0 = lane * 4; const float4 v = *(const float4*)(YCV + (size_t)m * 256 + c0);
      const float rc = rsqrtf(wave_sum(v.x * v.x + v.y * v.y + v.z * v.z + v.w * v.w) * (1.f / 256.f) + 1e-6f);
      const float* g = gout + 768 + c0; uint2 w; w.x = f2bf(v.x * rc * g[0]) | (f2bf(v.y * rc * g[1]) << 16); w.y = f2bf(v.z * rc * g[2]) | (f2bf(v.w * rc * g[3]) << 16);
      *((uint2*)(Y + (size_t)m * 1024 + 768) + lane) = w; }
}


namespace att {
typedef short bf16x8 __attribute__((ext_vector_type(8)));
typedef short s16x4 __attribute__((ext_vector_type(4)));
typedef float f32x4 __attribute__((ext_vector_type(4)));
typedef unsigned u32x4 __attribute__((ext_vector_type(4)));
#define ATT_LAS __attribute__((address_space(3)))
constexpr int KSTR = 144, VSTR = 136;
constexpr int KBUF = 64 * KSTR, VBUF = 64 * VSTR, SLOT = KBUF + VBUF;
constexpr int OFF_IMP = 2 * SLOT, IMP_LD = 257, OFF_SEL = OFF_IMP + 64 * IMP_LD * 4, LDS_BYTES = OFF_SEL + 64 * 8 * 4;

struct Stage { uint4 k, v; };
__device__ __forceinline__ void stage_load(Stage& r, const bf16_t* kbase, const bf16_t* vbase, size_t stride, int tid) {
    const int key = tid >> 3, c8 = (tid & 7) * 8;
    r.k = *(const uint4*)(kbase + (size_t)key * stride + c8); r.v = *(const uint4*)(vbase + (size_t)key * stride + c8);
}
__device__ __forceinline__ void stage_write(const Stage& r, ATT_LAS unsigned char* slot, int tid) {
    const int key = tid >> 3, c8 = (tid & 7) * 8;
    *(ATT_LAS u32x4*)(slot + key * KSTR + c8 * 2) = (u32x4){r.k.x, r.k.y, r.k.z, r.k.w};
    ATT_LAS unsigned short* vt = (ATT_LAS unsigned short*)(slot + KBUF) + key;
    constexpr int VS = VSTR / 2;
    vt[(c8 + 0) * VS] = (unsigned short)(r.v.x & 0xffff); vt[(c8 + 1) * VS] = (unsigned short)(r.v.x >> 16);
    vt[(c8 + 2) * VS] = (unsigned short)(r.v.y & 0xffff); vt[(c8 + 3) * VS] = (unsigned short)(r.v.y >> 16);
    vt[(c8 + 4) * VS] = (unsigned short)(r.v.z & 0xffff); vt[(c8 + 5) * VS] = (unsigned short)(r.v.z >> 16);
    vt[(c8 + 6) * VS] = (unsigned short)(r.v.w & 0xffff); vt[(c8 + 7) * VS] = (unsigned short)(r.v.w >> 16);
}
__device__ __forceinline__ unsigned pk_bf16(float lo, float hi) { return f2bf(lo) | (f2bf(hi) << 16); }

template <int MODE>
__device__ __forceinline__ void block_compute(const ATT_LAS unsigned char* slot, const bf16x8 (&qf)[2][2], f32x4 (&O)[2][4], float (&l)[2], const int (&hi)[2], const int (&lo)[2],
                                              const float (&pscale)[2], ATT_LAS float* imp_row0, ATT_LAS float* imp_row1, int jb, int lane) {
    const int col16 = lane & 15, q4 = lane >> 4;
#pragma unroll
    for (int ks = 0; ks < 2; ++ks) {
        bf16x8 kf[2][2];
#pragma unroll
        for (int kt = 0; kt < 2; ++kt)
#pragma unroll
            for (int st = 0; st < 2; ++st) kf[kt][st] = *(const ATT_LAS bf16x8*)(slot + (16 * (2 * ks + kt) + col16) * KSTR + st * 64 + q4 * 16);
        bf16x8 vf[4];
        if (MODE != 0) {
#pragma unroll
            for (int dt = 0; dt < 4; ++dt) { const ATT_LAS unsigned char* vp = slot + KBUF + (16 * dt + col16) * VSTR + (32 * ks + 4 * q4) * 2;
                const s16x4 a = *(const ATT_LAS s16x4*)vp, b = *(const ATT_LAS s16x4*)(vp + 32);
                vf[dt] = (bf16x8){a[0], a[1], a[2], a[3], b[0], b[1], b[2], b[3]}; }
        }
#pragma unroll
        for (int cg = 0; cg < 2; ++cg) {
            f32x4 s0 = {0.f, 0.f, 0.f, 0.f}, s1 = {0.f, 0.f, 0.f, 0.f};
            s0 = __builtin_amdgcn_mfma_f32_16x16x32_bf16(kf[0][0], qf[cg][0], s0, 0, 0, 0);
            s0 = __builtin_amdgcn_mfma_f32_16x16x32_bf16(kf[0][1], qf[cg][1], s0, 0, 0, 0);
            s1 = __builtin_amdgcn_mfma_f32_16x16x32_bf16(kf[1][0], qf[cg][0], s1, 0, 0, 0);
            s1 = __builtin_amdgcn_mfma_f32_16x16x32_bf16(kf[1][1], qf[cg][1], s1, 0, 0, 0);
            const int kk0 = 32 * ks + 4 * q4;
            float p0[4], p1[4];
#pragma unroll
            for (int r = 0; r < 4; ++r) {
                const int ka = kk0 + r, kb = kk0 + 16 + r;
                p0[r] = (ka <= hi[cg] && ka > lo[cg]) ? __builtin_amdgcn_exp2f(s0[r]) : 0.f;
                p1[r] = (kb <= hi[cg] && kb > lo[cg]) ? __builtin_amdgcn_exp2f(s1[r]) : 0.f;
            }
            if (MODE == 1) {
#pragma unroll
                for (int r = 0; r < 4; ++r) { p0[r] *= pscale[cg]; p1[r] *= pscale[cg]; }
                float w0 = (p0[0] + p0[1]) + (p0[2] + p0[3]), c0 = p0[3], w1 = (p1[0] + p1[1]) + (p1[2] + p1[3]), c1 = p1[3];
                w0 += __shfl_xor(w0, 1); w0 += __shfl_xor(w0, 2); c0 += __shfl_xor(c0, 1); c0 += __shfl_xor(c0, 2);
                w1 += __shfl_xor(w1, 1); w1 += __shfl_xor(w1, 2); c1 += __shfl_xor(c1, 1); c1 += __shfl_xor(c1, 2);
                if ((col16 & 3) == 0) { ATT_LAS float* ir = (cg == 0 ? imp_row0 : imp_row1) + jb + 8 * ks + q4;
                    __hip_atomic_fetch_add(ir, w0, __ATOMIC_RELAXED, __HIP_MEMORY_SCOPE_WORKGROUP); __hip_atomic_fetch_add(ir + 4, w1, __ATOMIC_RELAXED, __HIP_MEMORY_SCOPE_WORKGROUP);
                    __hip_atomic_fetch_add(ir + 1, c0, __ATOMIC_RELAXED, __HIP_MEMORY_SCOPE_WORKGROUP); __hip_atomic_fetch_add(ir + 5, c1, __ATOMIC_RELAXED, __HIP_MEMORY_SCOPE_WORKGROUP); }
            } else {
                l[cg] += ((p0[0] + p0[1]) + (p0[2] + p0[3])) + ((p1[0] + p1[1]) + (p1[2] + p1[3]));
            }
            if (MODE != 0) {
                union { bf16x8 v; unsigned u[4]; } pf;
                pf.u[0] = pk_bf16(p0[0], p0[1]); pf.u[1] = pk_bf16(p0[2], p0[3]); pf.u[2] = pk_bf16(p1[0], p1[1]); pf.u[3] = pk_bf16(p1[2], p1[3]);
#pragma unroll
                for (int dt = 0; dt < 4; ++dt) O[cg][dt] = __builtin_amdgcn_mfma_f32_16x16x32_bf16(vf[dt], pf.v, O[cg][dt], 0, 0, 0);
            }
        }
    }
}

struct Tensors { const bf16_t* Z; const bf16_t* KC; const bf16_t* VC; const float* gates; float* YATT; };

__device__ __forceinline__ void attn_item(ATT_LAS unsigned char* lds, const Tensors& T, int b, int h, int tile) {
    int tid = threadIdx.x; asm volatile("" : "+v"(tid));
    const int lane = tid & 63, wv = tid >> 6, col16 = lane & 15, q4 = lane >> 4, g = col16 & 3;
    const int t0 = tile * 64, cur = tile, bh = b * 2 + h;
    ATT_LAS float* imp = (ATT_LAS float*)(lds + OFF_IMP); ATT_LAS unsigned* sel = (ATT_LAS unsigned*)(lds + OFF_SEL);
    int tq[2]; size_t mrow[2];
#pragma unroll
    for (int cg = 0; cg < 2; ++cg) { tq[cg] = wv * 8 + cg * 4 + (col16 >> 2); mrow[cg] = (size_t)b * SEQ + t0 + tq[cg]; }
    const int hq = h * 4 + g;
    bf16x8 qf[2][2];
#pragma unroll
    for (int cg = 0; cg < 2; ++cg)
#pragma unroll
        for (int st = 0; st < 2; ++st) qf[cg][st] = *(const bf16x8*)(T.Z + mrow[cg] * NZ + hq * 64 + st * 32 + q4 * 8);
    __syncthreads();
    for (int e = tid; e < 64 * IMP_LD; e += 512) imp[e] = 0.f;
    for (int e = tid; e < 64 * 8; e += 512) sel[e] = 0u;
    f32x4 OT[2][4];
#pragma unroll
    for (int cg = 0; cg < 2; ++cg)
#pragma unroll
        for (int dt = 0; dt < 4; ++dt) OT[cg][dt] = (f32x4){0.f, 0.f, 0.f, 0.f};
    float l[2]; int hi[2], lo[2]; float psc[2] = {1.f, 1.f};
    ATT_LAS float* imp0 = imp + tq[0] * IMP_LD; ATT_LAS float* imp1 = imp + tq[1] * IMP_LD;
    Stage sr;
    const int nk = min(NC, t0 / 16 + 3), nch = (nk + 63) >> 6;
    const bf16_t* kcb = T.KC + (size_t)bh * 1024 * 64; const bf16_t* vcb = T.VC + (size_t)bh * 1024 * 64;
    int nmax[2];
#pragma unroll
    for (int cg = 0; cg < 2; ++cg) nmax[cg] = (t0 + tq[cg] - 31) >> 4;
    l[0] = 0.f; l[1] = 0.f; lo[0] = -1; lo[1] = -1;
    for (int pass = 0; pass < 2; ++pass) {
        if (pass == 1) {
#pragma unroll
            for (int cg = 0; cg < 2; ++cg) { float lt = l[cg]; lt += __shfl_xor(lt, 16); lt += __shfl_xor(lt, 32); psc[cg] = lt > 0.f ? 1.f / lt : 0.f; }
        }
        stage_load(sr, kcb, vcb, 64, tid);
        for (int c = 0; c < nch; ++c) {
            ATT_LAS unsigned char* slot = lds + (c & 1) * SLOT;
            stage_write(sr, slot, tid);
            if (c + 1 < nch) stage_load(sr, kcb + (size_t)(c + 1) * 64 * 64, vcb + (size_t)(c + 1) * 64 * 64, 64, tid);
            __syncthreads();
            hi[0] = nmax[0] - 64 * c; hi[1] = nmax[1] - 64 * c;
            if (pass == 0) block_compute<0>(slot, qf, OT, l, hi, lo, psc, imp0, imp1, 16 * c, lane);
            else block_compute<1>(slot, qf, OT, l, hi, lo, psc, imp0, imp1, 16 * c, lane);
        }
        __syncthreads();
    }
#pragma unroll
    for (int cg = 0; cg < 2; ++cg)
#pragma unroll
        for (int dt = 0; dt < 4; ++dt) OT[cg][dt] = OT[cg][dt] * T.gates[mrow[cg] * 24 + hq * 3 + 0];
    {
        const int q = tid >> 3, sub = tid & 7;
        if (cur + 1 <= 16) { if (sub == 0) sel[q * 8] = (1u << (cur + 1)) - 1u; }
        else {
            if (sub == 0) { sel[q * 8] |= 1u; sel[q * 8 + (cur >> 5)] |= 1u << (cur & 31); sel[q * 8 + ((cur - 1) >> 5)] |= 1u << ((cur - 1) & 31); }
#pragma unroll 1
            for (int it = 0; it < 13; ++it) {
                __syncthreads();
                float best = -1.f; int bj = 0x7fffffff;
                for (int j = 1 + sub; j <= cur - 2; j += 8) { const float v = imp[q * IMP_LD + j]; if (v > best) { best = v; bj = j; } }
#pragma unroll
                for (int off = 1; off <= 4; off <<= 1) { const float ob = __shfl_xor(best, off); const int oj = __shfl_xor(bj, off); if (ob > best || (ob == best && oj < bj)) { best = ob; bj = oj; } }
                if (sub == 0 && bj <= cur - 2) { imp[q * IMP_LD + bj] = -2.f; sel[q * 8 + (bj >> 5)] |= 1u << (bj & 31); }
            }
        }
    }
    __syncthreads();
    ATT_LAS f32x4* stash = (ATT_LAS f32x4*)(lds + OFF_IMP) + tid;
#pragma unroll
    for (int cg = 0; cg < 2; ++cg)
#pragma unroll
        for (int dt = 0; dt < 4; ++dt) stash[(cg * 4 + dt) * 512] = OT[cg][dt];
    const bf16_t* zb = T.Z + (size_t)b * SEQ * NZ + ZKV + h * 64;
#define O OT
    {
        l[0] = 0.f; l[1] = 0.f; lo[0] = -1; lo[1] = -1;
#pragma unroll
        for (int cg = 0; cg < 2; ++cg)
#pragma unroll
            for (int dt = 0; dt < 4; ++dt) O[cg][dt] = (f32x4){0.f, 0.f, 0.f, 0.f};
        stage_load(sr, zb + 2 * 128, zb + 3 * 128, NZ, tid);
        unsigned sw[2] = {0u, 0u};
        for (int j = 0; j <= cur; ++j) {
            ATT_LAS unsigned char* slot = lds + (j & 1) * SLOT;
            stage_write(sr, slot, tid);
            if (j + 1 <= cur) stage_load(sr, zb + (size_t)(j + 1) * 64 * NZ + 2 * 128, zb + (size_t)(j + 1) * 64 * NZ + 3 * 128, NZ, tid);
            __syncthreads();
            if ((j & 31) == 0) { sw[0] = sel[tq[0] * 8 + (j >> 5)]; sw[1] = sel[tq[1] * 8 + (j >> 5)]; }
#pragma unroll
            for (int cg = 0; cg < 2; ++cg) hi[cg] = ((sw[cg] >> (j & 31)) & 1u) ? (j == cur ? tq[cg] : 63) : -1;
            if (__any(hi[0] >= 0 || hi[1] >= 0)) block_compute<2>(slot, qf, O, l, hi, lo, psc, imp0, imp1, 0, lane);
        }
        __syncthreads();
#pragma unroll
        for (int cg = 0; cg < 2; ++cg) { float lt = l[cg]; lt += __shfl_xor(lt, 16); lt += __shfl_xor(lt, 32); const float sc = T.gates[mrow[cg] * 24 + hq * 3 + 1] / lt;
#pragma unroll
            for (int dt = 0; dt < 4; ++dt) stash[(cg * 4 + dt) * 512] = stash[(cg * 4 + dt) * 512] + O[cg][dt] * sc; }
    }
    {
        l[0] = 0.f; l[1] = 0.f;
#pragma unroll
        for (int cg = 0; cg < 2; ++cg)
#pragma unroll
            for (int dt = 0; dt < 4; ++dt) O[cg][dt] = (f32x4){0.f, 0.f, 0.f, 0.f};
        const int j0 = max(0, cur - 8);
        stage_load(sr, zb + (size_t)j0 * 64 * NZ + 4 * 128, zb + (size_t)j0 * 64 * NZ + 5 * 128, NZ, tid);
        for (int j = j0; j <= cur; ++j) {
            ATT_LAS unsigned char* slot = lds + (j & 1) * SLOT;
            stage_write(sr, slot, tid);
            if (j + 1 <= cur) stage_load(sr, zb + (size_t)(j + 1) * 64 * NZ + 4 * 128, zb + (size_t)(j + 1) * 64 * NZ + 5 * 128, NZ, tid);
            __syncthreads();
#pragma unroll
            for (int cg = 0; cg < 2; ++cg) { hi[cg] = (j == cur) ? tq[cg] : 63; lo[cg] = (j == cur - 8) ? tq[cg] : -1; }
            block_compute<2>(slot, qf, O, l, hi, lo, psc, imp0, imp1, 0, lane);
        }
#pragma unroll
        for (int cg = 0; cg < 2; ++cg) { float lt = l[cg]; lt += __shfl_xor(lt, 16); lt += __shfl_xor(lt, 32); const float sc = T.gates[mrow[cg] * 24 + hq * 3 + 2] / lt;
#pragma unroll
            for (int dt = 0; dt < 4; ++dt) *(f32x4*)(T.YATT + mrow[cg] * 512 + hq * 64 + 16 * dt + 4 * q4) = stash[(cg * 4 + dt) * 512] + O[cg][dt] * sc; }
    }
#undef O
}
}

__global__ void __launch_bounds__(512, 2) k_attn(att::Tensors T) {
    extern __shared__ __attribute__((aligned(16))) unsigned char lds_a[];
    for (int it = 0; it < 4; ++it) {
        const int c = blockIdx.x; const int tile = (it & 1) ? 255 - c : c; const int bh = it;
        att::attn_item((ATT_LAS unsigned char*)lds_a, T, bh >> 1, bh & 1, tile);
    }
}

constexpr size_t MiB = 1u << 20;
constexpr size_t WS_WIN = 1 * MiB;
constexpr size_t WS_WOUT = 11 * MiB;
constexpr size_t WS_W1 = 15 * MiB;
constexpr size_t WS_W2 = 31 * MiB;
constexpr size_t WS_RSTD = 47 * MiB;
constexpr size_t WS_LRUS = 48 * MiB;
constexpr size_t WS_XN = 65 * MiB;
constexpr size_t WS_Z = 129 * MiB;
constexpr size_t WS_GATES = 273 * MiB;
constexpr size_t WS_KC = 276 * MiB, WS_VC = 277 * MiB;
constexpr size_t WS_YATT = 278 * MiB;
constexpr size_t WS_HLOC = 342 * MiB;
constexpr size_t WS_YCV = 374 * MiB;
constexpr size_t WS_Y = 406 * MiB;
constexpr size_t WS_PC = 470 * MiB;
constexpr size_t WS_H = 129 * MiB;
constexpr size_t WS_END = 502 * MiB;

extern "C" void kernel_launch(void* const* d_in, const int* in_sizes, int n_in, void* d_out, int out_size, void* d_ws, size_t ws_size, hipStream_t stream) {
    if (n_in != 24 || in_sizes[0] != MTOK * D_MODEL || out_size != MTOK * D_MODEL || ws_size < WS_END) {
        fprintf(stderr, "kernel_launch: unexpected shapes: n_in %d in0 %d out %d ws %zu (need %zu)\n", n_in, n_in > 0 ? in_sizes[0] : -1, out_size, ws_size, (size_t)WS_END); return; }
    const float* x = (const float*)d_in[0]; const float* attn_norm = (const float*)d_in[1]; const float* w_in = (const float*)d_in[2]; const float* q_norm = (const float*)d_in[3];
    const float* k_norm = (const float*)d_in[4]; const float* cmp_pos = (const float*)d_in[5]; const float* cmp_w1 = (const float*)d_in[6]; const float* cmp_w2 = (const float*)d_in[7];
    const float* lru_conv_w = (const float*)d_in[8]; const float* lru_conv_b = (const float*)d_in[9]; const float* lru_wa = (const float*)d_in[10]; const float* lru_ba = (const float*)d_in[11];
    const float* lru_wx = (const float*)d_in[12]; const float* lru_bx = (const float*)d_in[13]; const float* lru_lambda = (const float*)d_in[14]; const float* cv_dw_w = (const float*)d_in[15];
    const float* cv_dw_b = (const float*)d_in[16]; const float* cv_ln_g = (const float*)d_in[17]; const float* cv_ln_b = (const float*)d_in[18]; const float* out_norm = (const float*)d_in[19];
    const float* w_out = (const float*)d_in[20]; const float* mlp_norm = (const float*)d_in[21]; const float* mlp_w1 = (const float*)d_in[22]; const float* mlp_w2 = (const float*)d_in[23];
    unsigned char* ws = (unsigned char*)d_ws; float* out = (float*)d_out;
    bf16_t* WinT = (bf16_t*)(ws + WS_WIN); bf16_t* WoutT = (bf16_t*)(ws + WS_WOUT); bf16_t* W1T = (bf16_t*)(ws + WS_W1); bf16_t* W2T = (bf16_t*)(ws + WS_W2);
    float* rstd = (float*)(ws + WS_RSTD); float* SP = (float*)(ws + WS_LRUS); float* SH = SP + 2 * 512 * 256; float* CIN = SH + 2 * 512 * 256;
    bf16_t* XN = (bf16_t*)(ws + WS_XN); bf16_t* Z = (bf16_t*)(ws + WS_Z); float* gates = (float*)(ws + WS_GATES); bf16_t* KC = (bf16_t*)(ws + WS_KC); bf16_t* VC = (bf16_t*)(ws + WS_VC);
    float* YATT = (float*)(ws + WS_YATT); float* HLOC = (float*)(ws + WS_HLOC); float* YCV = (float*)(ws + WS_YCV); bf16_t* Y = (bf16_t*)(ws + WS_Y); float* PC = (float*)(ws + WS_PC); bf16_t* H = (bf16_t*)(ws + WS_H);

    static bool attr_done = false;
    if (!attr_done) {
        (void)hipFuncSetAttribute((const void*)k_gemm<pg8::EpiBf16<0>>, hipFuncAttributeMaxDynamicSharedMemorySize, pg8::STAGE_BYTES);
        (void)hipFuncSetAttribute((const void*)k_gemm<pg8::EpiBf16<2>>, hipFuncAttributeMaxDynamicSharedMemorySize, pg8::STAGE_BYTES);
        (void)hipFuncSetAttribute((const void*)k_gemm<pg8::EpiResF32>, hipFuncAttributeMaxDynamicSharedMemorySize, pg8::STAGE_BYTES);
        (void)hipFuncSetAttribute((const void*)k_attn, hipFuncAttributeMaxDynamicSharedMemorySize, att::LDS_BYTES);
        attr_done = true;
    }
    for (int l = 0; l < 2; ++l) {
        const float* wi = w_in + (size_t)l * D_MODEL * N_IN;
        k_transpose<<<dim3(1280 / 32, 1024 / 32), 256, 0, stream>>>(wi, 1024, N_IN, 0, WinT + (size_t)l * NZ * 1024, 0);
        k_transpose<<<dim3(1024 / 32, 1024 / 32), 256, 0, stream>>>(wi, 1024, N_IN, OFF_LRU_SRC, WinT + (size_t)l * NZ * 1024, 1280);
        k_transpose<<<dim3(1024 / 32, 1024 / 32), 256, 0, stream>>>(w_out + (size_t)l * 1024 * 1024, 1024, 1024, 0, WoutT + (size_t)l * 1024 * 1024, 0);
        k_transpose<<<dim3(4096 / 32, 1024 / 32), 256, 0, stream>>>(mlp_w1 + (size_t)l * 1024 * 4096, 1024, 4096, 0, W1T + (size_t)l * 4096 * 1024, 0);
        k_transpose<<<dim3(1024 / 32, 4096 / 32), 256, 0, stream>>>(mlp_w2 + (size_t)l * 4096 * 1024, 4096, 1024, 0, W2T + (size_t)l * 1024 * 4096, 0);
    }
    const int G = 256;
    for (int l = 0; l < 2; ++l) {
        const float* xin = l == 0 ? x : out;
        k_rmsnorm<<<MTOK / 4, 256, 0, stream>>>(xin, attn_norm + l * 1024, XN, rstd);
        k_gates<<<MTOK / 32, 192, 0, stream>>>(xin, attn_norm + l * 1024, w_in + (size_t)l * D_MODEL * N_IN, rstd, gates);
        { pg8::Gemm g{XN, WinT + (size_t)l * NZ * 1024, MTOK, NZ, 1024}; pg8::EpiBf16<0> E{Z, NZ}; k_gemm<<<G, 512, pg8::STAGE_BYTES, stream>>>(g, E); }
        k_qknorm<<<MTOK / 4, 256, 0, stream>>>(Z, q_norm + l * 64, k_norm + l * 192);
        k_compress<<<dim3(512, 2), 128, 0, stream>>>(Z, cmp_pos + (size_t)l * 2 * 2048, cmp_w1 + (size_t)l * 2 * 2048 * 128, cmp_w2 + (size_t)l * 2 * 128 * 64, k_norm + l * 192, KC, VC);
        k_lru1<<<1024, 256, 0, stream>>>(Z, lru_conv_w + l * 1024, lru_conv_b + l * 256, lru_wa + l * 8192, lru_ba + l * 256, lru_wx + l * 8192, lru_bx + l * 256, lru_lambda + l * 256, HLOC, PC, SP, SH);
        k_lru2<<<2, 256, 0, stream>>>(SP, SH, CIN);
        k_conv<<<2048, 256, 0, stream>>>(Z, cv_dw_w + l * 31 * 256, cv_dw_b + l * 256, cv_ln_g + l * 256, cv_ln_b + l * 256, YCV);
        { att::Tensors T{Z, KC, VC, gates, YATT}; k_attn<<<256, 512, att::LDS_BYTES, stream>>>(T); }
        k_groupnorm<<<MTOK / 4, 256, 0, stream>>>(YATT, HLOC, PC, CIN, Z, YCV, out_norm + l * 1024, Y);
        { pg8::Gemm g{Y, WoutT + (size_t)l * 1024 * 1024, MTOK, 1024, 1024}; pg8::EpiResF32 E{xin, out, 1024}; k_gemm<<<G, 512, pg8::STAGE_BYTES, stream>>>(g, E); }
        k_rmsnorm<<<MTOK / 4, 256, 0, stream>>>(out, mlp_norm + l * 1024, XN, rstd);
        { pg8::Gemm g{XN, W1T + (size_t)l * 4096 * 1024, MTOK, 4096, 1024}; pg8::EpiBf16<2> E{H, 4096}; k_gemm<<<G, 512, pg8::STAGE_BYTES, stream>>>(g, E); }
        { pg8::Gemm g{H, W2T + (size_t)l * 1024 * 4096, MTOK, 1024, 4096}; pg8::EpiResF32 E{out, out, 1024}; k_gemm<<<G, 512, pg8::STAGE_BYTES, stream>>>(g, E); }
    }
}
```

```cpp
#include <hip/hip_runtime.h>
#include <hip/hip_cooperative_groups.h>
namespace cg = cooperative_groups;
#include <cstdio>
#include <cstdint>

constexpr int D_MODEL = 1024, BATCH = 2, SEQ = 16384, MTOK = BATCH * SEQ, N_IN = 2328, NZ = 2304, D_FF = 4096;
constexpr int ZQ = 0, ZKV = 512, ZLX = 1280, ZLG = 1536, ZCV = 1792;
constexpr int OFF_GATE_SRC = 1280, OFF_LRU_SRC = 1304;
constexpr int NC = 1023, NSLC = 256;

typedef unsigned short bf16_t;
__device__ __forceinline__ unsigned f2bf(float f) { unsigned u = __builtin_bit_cast(unsigned, f); return (u + 0x7fffu + ((u >> 16) & 1u)) >> 16; }
__device__ __forceinline__ float bf2f(unsigned short h) { return __builtin_bit_cast(float, (unsigned)h << 16); }
__device__ __forceinline__ float wave_sum(float v) {
#pragma unroll
    for (int o = 1; o < 64; o <<= 1) v += __shfl_xor(v, o);
    return v;
}
__device__ __forceinline__ float gelu_tanh(float x) { const float u = 0.7978845608028654f * (x + 0.044715f * x * x * x); return 0.5f * x * (1.f + tanhf(u)); }
__device__ __forceinline__ float sigmoidf_(float x) { return 1.f / (1.f + __expf(-x)); }

namespace pg8 {
#define PG8_LAS __attribute__((address_space(3)))
using ::bf16_t;
typedef short bf16x8 __attribute__((ext_vector_type(8)));
typedef float f32x4 __attribute__((ext_vector_type(4)));
typedef unsigned u32x4 __attribute__((ext_vector_type(4)));
constexpr int BM = 256, BK = 64, HALF = 128, HTB = HALF * BK * 2  , STAGE_BYTES = 8 * HTB, NXCD = 8, WGM = 8;

__host__ __device__ __forceinline__ int lds_byte(int r, int c) { const int st = (r >> 4) * 2 + (c >> 5), rr = r & 15, cc = c & 31, ob = rr * 64 + cc * 2; return st * 1024 + (ob ^ (((ob >> 9) & 1) << 5)); }
__host__ __device__ __forceinline__ void stage_rc(int b, int& R, int& C) { const int st = b / 1024, sb = b % 1024, swz = sb ^ (((sb >> 9) & 1) << 5); R = (st >> 1) * 16 + swz / 64; C = (st & 1) * 32 + (swz % 64) / 2; }
__host__ __device__ __forceinline__ int perm32(int rho) { const int n = rho >> 4, i = rho & 15; return 8 * (i >> 2) + 4 * n + (i & 3); }

struct Unit { int pm, pn; };
struct Gemm { const bf16_t* A; const bf16_t* Bt; int M, N, K, pad; };

struct StaticOrder {
    int nM, nN, nwg, G, c;
    __host__ __device__ void init(int M, int N, int G_, int c_) { nM = M / BM; nN = N / BM; nwg = nM * nN; G = G_; c = c_; }
    __host__ __device__ bool next(int i, Unit& u) const {
        const long L = (long)i * G + c; if (L >= nwg) return false;
        int wgid = (int)L; { const int q = nwg / NXCD, r = nwg % NXCD, xcd = wgid % NXCD, off = wgid / NXCD; wgid = (xcd < r ? xcd * (q + 1) : r * (q + 1) + (xcd - r) * q) + off; }
        const int nig = WGM * nN, gid = wgid / nig, fm = gid * WGM, gsz = (nM - fm) < WGM ? (nM - fm) : WGM;
        u.pm = fm + ((wgid % nig) % gsz); u.pn = (wgid % nig) / gsz; return true;
    }
    __device__ __forceinline__ void a_ready(const Unit&) const {}
    __device__ __forceinline__ void done(const Unit&) const {}
};


__device__ __forceinline__ unsigned cvt_pk_bf16(float lo, float hi) { unsigned r; asm volatile("v_cvt_pk_bf16_f32 %0, %1, %2" : "=v"(r) : "v"(lo), "v"(hi)); return r; }

template <int ACT  > struct EpiBf16 {
    static constexpr bool PERM = true, AFTER_DRAIN = false;
    bf16_t* O; int ldc, pad;
    __device__ __forceinline__ void operator()(const f32x4 (&acc)[2][2][4][2], const Unit& u, int wr, int wc, int fr, int fq) const {
        const int row0 = u.pm * BM + wr * 64 + fr; const int col0 = u.pn * BM + wc * 32 + 8 * fq;
#pragma unroll
        for (int ai = 0; ai < 2; ++ai)
#pragma unroll
            for (int m = 0; m < 4; ++m) { bf16_t* rowp = O + (size_t)(row0 + ai * HALF + m * 16) * ldc + col0;
#pragma unroll
                for (int bj = 0; bj < 2; ++bj) { f32x4 v0 = acc[ai][bj][m][0], v1 = acc[ai][bj][m][1];
                    if (ACT == 2) {
#pragma unroll
                        for (int e = 0; e < 4; ++e) { float a = v0[e] > 0.f ? v0[e] : 0.f; v0[e] = a * a; float b = v1[e] > 0.f ? v1[e] : 0.f; v1[e] = b * b; } }
                    u32x4 w; w.x = cvt_pk_bf16(v0[0], v0[1]); w.y = cvt_pk_bf16(v0[2], v0[3]); w.z = cvt_pk_bf16(v1[0], v1[1]); w.w = cvt_pk_bf16(v1[2], v1[3]);
                    *(u32x4*)(rowp + bj * HALF) = w; } }
    }
};
struct EpiResF32 {
    static constexpr bool PERM = false, AFTER_DRAIN = false;
    const float* base; float* C; int ldc, pad;
    __device__ __forceinline__ void operator()(const f32x4 (&acc)[2][2][4][2], const Unit& u, int wr, int wc, int fr, int fq) const {
        const int row0 = u.pm * BM + wr * 64 + fr, col0 = u.pn * BM + wc * 32 + 4 * fq;
#pragma unroll
        for (int ai = 0; ai < 2; ++ai)
#pragma unroll
            for (int m = 0; m < 4; ++m) { const size_t off = (size_t)(row0 + ai * HALF + m * 16) * ldc + col0;
#pragma unroll
                for (int bj = 0; bj < 2; ++bj)
#pragma unroll
                    for (int n = 0; n < 2; ++n) { const f32x4 b = *(const f32x4*)(base + off + bj * HALF + n * 16); *(f32x4*)(C + off + bj * HALF + n * 16) = acc[ai][bj][m][n] + b; } }
    }
};

template <class Epi, class Sched, bool ALIGN_EPI = false, bool SP2 = false>
__device__ __forceinline__ void gemm_phase(PG8_LAS unsigned char* lds, const Gemm g, const Sched& S, const Epi& E) {
    int tid_ = threadIdx.x; asm volatile("" : "+v"(tid_));
    const int tid = tid_, wid = __builtin_amdgcn_readfirstlane(tid >> 6), lane = tid & 63, wr = wid >> 2, wc = wid & 3, fr = lane & 15, fq = lane >> 4;
    const int K = g.K, nt = K / BK;
    unsigned voffA[2], voffB[2];
#pragma unroll
    for (int i = 0; i < 2; ++i) { int R, C; stage_rc(tid * 16 + i * 8192, R, C); const int Rb = Epi::PERM ? ((R & ~31) + perm32(R & 31)) : R;
        voffA[i] = (unsigned)(R * K + C) * 2u; voffB[i] = (unsigned)(Rb * K + C) * 2u; }
    const size_t kstep = (size_t)(BK * 2);
    const size_t hstep = (size_t)HALF * K * 2;
    const size_t tstep = 2 * hstep;
    const unsigned ldsw = (unsigned)wid * 1024u;
    const int aoff = lds_byte(wr * 64 + fr, fq * 8), boff = lds_byte(wc * 32 + fr, fq * 8);
#define PG8_SA(b, h) (((b) * 2 + (h)) * HTB)
#define PG8_SB(b, h) ((4 + (b) * 2 + (h)) * HTB)
#define PG8_STAGE(bufoff, gbase, voff) do { _Pragma("unroll") for (int _i = 0; _i < 2; ++_i) \
        __builtin_amdgcn_global_load_lds((const unsigned*)((const char*)(gbase) + (voff)[_i]), (PG8_LAS unsigned*)(lds + (bufoff) + ldsw + _i * 8192), 16, 0, 0); } while (0)
#define PG8_LDA(dst, b, h) do { _Pragma("unroll") for (int m = 0; m < 4; ++m) _Pragma("unroll") for (int k = 0; k < 2; ++k) dst[m][k] = *(const PG8_LAS bf16x8*)(lds + PG8_SA(b, h) + aoff + m * 2048 + k * 1024); } while (0)
#define PG8_LDB(dst, b, h) do { _Pragma("unroll") for (int n = 0; n < 2; ++n) _Pragma("unroll") for (int k = 0; k < 2; ++k) dst[n][k] = *(const PG8_LAS bf16x8*)(lds + PG8_SB(b, h) + boff + n * 2048 + k * 1024); } while (0)
#define PG8_MMA(ai, bj, At, Bt) do { __builtin_amdgcn_s_setprio(1); _Pragma("unroll") for (int m = 0; m < 4; ++m) _Pragma("unroll") for (int n = 0; n < 2; ++n) _Pragma("unroll") for (int k = 0; k < 2; ++k) \
        acc[ai][bj][m][n] = __builtin_amdgcn_mfma_f32_16x16x32_bf16(Bt[n][k], At[m][k], acc[ai][bj][m][n], 0, 0, 0); __builtin_amdgcn_s_setprio(0); } while (0)
#define PG8_WAIT_V(n) asm volatile("s_waitcnt vmcnt(" #n ")" ::: "memory")
#define PG8_WAIT_L(n) asm volatile("s_waitcnt lgkmcnt(" #n ")" ::: "memory")
#define PG8_BAR __builtin_amdgcn_s_barrier()
#define PG8_SCHED __builtin_amdgcn_sched_barrier(0)
    Unit cur, nxt; int ui = 0;
    if (!S.next(0, cur)) return;
    f32x4 acc[2][2][4][2];
#pragma unroll
    for (int a = 0; a < 2; ++a)
#pragma unroll
        for (int b = 0; b < 2; ++b)
#pragma unroll
            for (int m = 0; m < 4; ++m)
#pragma unroll
                for (int n = 0; n < 2; ++n) acc[a][b][m][n] = (f32x4){0.f, 0.f, 0.f, 0.f};
    bf16x8 At[4][2], B0[2][2], B1[2][2];
    const char* cA = (const char*)g.A + (size_t)cur.pm * tstep; const char* cB = (const char*)g.Bt + (size_t)cur.pn * tstep;
    S.a_ready(cur);
    if constexpr (SP2) {
        PG8_STAGE(PG8_SB(0, 0), cB, voffB); PG8_STAGE(PG8_SB(0, 1), cB + hstep, voffB); PG8_STAGE(PG8_SA(0, 0), cA, voffA); PG8_STAGE(PG8_SA(0, 1), cA + hstep, voffA);
        if (wr == 1) PG8_BAR;
        PG8_WAIT_V(2); PG8_BAR;
        PG8_STAGE(PG8_SB(1, 0), cB + kstep, voffB); PG8_STAGE(PG8_SA(1, 0), cA + kstep, voffA); PG8_STAGE(PG8_SB(1, 1), cB + hstep + kstep, voffB);
        PG8_WAIT_V(6); PG8_BAR;
    } else {
        PG8_STAGE(PG8_SB(0, 0), cB, voffB); PG8_STAGE(PG8_SA(0, 0), cA, voffA); PG8_STAGE(PG8_SB(0, 1), cB + hstep, voffB); PG8_STAGE(PG8_SA(0, 1), cA + hstep, voffA);
        if (wr == 1) PG8_BAR;
        PG8_WAIT_V(4); PG8_BAR;
        PG8_STAGE(PG8_SB(1, 0), cB + kstep, voffB); PG8_STAGE(PG8_SA(1, 0), cA + kstep, voffA); PG8_STAGE(PG8_SB(1, 1), cB + hstep + kstep, voffB);
        PG8_WAIT_V(6); PG8_BAR;
    }
    for (;;) {
        const bool has_next = S.next(ui + 1, nxt);
        const char* nA = has_next ? (const char*)g.A + (size_t)nxt.pm * tstep : cA; const char* nB = has_next ? (const char*)g.Bt + (size_t)nxt.pn * tstep : cB;
        for (int t = 0; t < nt; t += 2) {
            const bool last = (t == nt - 2);
            const char* a1 = cA + (size_t)(t + 1) * kstep;
            const char* a2 = last ? nA : cA + (size_t)(t + 2) * kstep; const char* b2 = last ? nB : cB + (size_t)(t + 2) * kstep;
            const char* a3 = a2 + kstep; const char* b3 = b2 + kstep;
            if (last && has_next) S.a_ready(nxt);
            if constexpr (SP2) {
            PG8_LDB(B0, 0, 0); PG8_LDB(B1, 0, 1); PG8_SCHED; PG8_LDA(At, 0, 0); PG8_STAGE(PG8_SA(1, 1), a1 + hstep, voffA);
            PG8_WAIT_V(8); PG8_WAIT_L(0); PG8_BAR; PG8_MMA(0, 0, At, B0); PG8_MMA(0, 1, At, B1); PG8_BAR; PG8_SCHED;
            PG8_LDA(At, 0, 1); PG8_STAGE(PG8_SB(0, 0), b2, voffB); PG8_STAGE(PG8_SB(0, 1), b2 + hstep, voffB); PG8_STAGE(PG8_SA(0, 0), a2, voffA);
            PG8_WAIT_V(8); PG8_WAIT_L(0); PG8_BAR; PG8_MMA(1, 0, At, B0); PG8_MMA(1, 1, At, B1); PG8_BAR; PG8_SCHED;
            PG8_LDB(B0, 1, 0); PG8_LDB(B1, 1, 1); PG8_SCHED; PG8_LDA(At, 1, 0); PG8_STAGE(PG8_SA(0, 1), a2 + hstep, voffA);
            PG8_WAIT_V(8); PG8_WAIT_L(0); PG8_BAR; PG8_MMA(0, 0, At, B0); PG8_MMA(0, 1, At, B1); PG8_BAR; PG8_SCHED;
            PG8_LDA(At, 1, 1); PG8_STAGE(PG8_SB(1, 0), b3, voffB); PG8_STAGE(PG8_SB(1, 1), b3 + hstep, voffB); PG8_STAGE(PG8_SA(1, 0), a3, voffA);
            PG8_WAIT_V(8); PG8_WAIT_L(0); PG8_BAR; PG8_MMA(1, 0, At, B0); PG8_MMA(1, 1, At, B1); PG8_BAR; PG8_SCHED;
            } else {
            PG8_LDB(B0, 0, 0); PG8_SCHED; PG8_LDA(At, 0, 0); PG8_STAGE(PG8_SA(1, 1), a1 + hstep, voffA);
            PG8_WAIT_L(8); PG8_BAR; PG8_WAIT_L(0); PG8_MMA(0, 0, At, B0); PG8_BAR; PG8_SCHED;
            PG8_LDB(B1, 0, 1); PG8_STAGE(PG8_SB(0, 0), b2, voffB);
            PG8_BAR; PG8_WAIT_L(0); PG8_MMA(0, 1, At, B1); PG8_BAR;
            PG8_LDA(At, 0, 1); PG8_STAGE(PG8_SA(0, 0), a2, voffA);
            PG8_BAR; PG8_WAIT_L(0); PG8_MMA(1, 0, At, B0); PG8_BAR; PG8_SCHED;
            PG8_STAGE(PG8_SB(0, 1), b2 + hstep, voffB);
            PG8_WAIT_V(6); PG8_BAR; PG8_MMA(1, 1, At, B1); PG8_BAR;
            PG8_LDB(B0, 1, 0); PG8_SCHED; PG8_LDA(At, 1, 0); PG8_STAGE(PG8_SA(0, 1), a2 + hstep, voffA);
            PG8_WAIT_L(8); PG8_BAR; PG8_WAIT_L(0); PG8_MMA(0, 0, At, B0); PG8_BAR; PG8_SCHED;
            PG8_LDB(B1, 1, 1); PG8_STAGE(PG8_SB(1, 0), b3, voffB);
            PG8_BAR; PG8_WAIT_L(0); PG8_MMA(0, 1, At, B1); PG8_BAR;
            PG8_LDA(At, 1, 1); PG8_STAGE(PG8_SA(1, 0), a3, voffA);
            PG8_BAR; PG8_WAIT_L(0); PG8_MMA(1, 0, At, B0); PG8_BAR; PG8_SCHED;
            PG8_STAGE(PG8_SB(1, 1), b3 + hstep, voffB);
            PG8_WAIT_V(6); PG8_BAR; PG8_MMA(1, 1, At, B1); PG8_BAR;
            }
        }
        if constexpr (ALIGN_EPI) { if (wr == 0) PG8_BAR; }
        if constexpr (!Epi::AFTER_DRAIN) { E(acc, cur, wr, wc, fr, fq); S.done(cur); }
        if (!has_next) break;
#pragma unroll
        for (int a = 0; a < 2; ++a)
#pragma unroll
            for (int b = 0; b < 2; ++b)
#pragma unroll
                for (int m = 0; m < 4; ++m)
#pragma unroll
                    for (int n = 0; n < 2; ++n) acc[a][b][m][n] = (f32x4){0.f, 0.f, 0.f, 0.f};
        cur = nxt; cA = nA; cB = nB; ++ui;
        if constexpr (ALIGN_EPI) { if (wr == 1) PG8_BAR; }
    }
    PG8_WAIT_V(0);
    if constexpr (!ALIGN_EPI) { if (wr == 0) PG8_BAR; }
    PG8_BAR;
    if constexpr (Epi::AFTER_DRAIN) { E.fused(acc, cur, wr, wc, fr, fq, lds, wid, lane); S.done(cur); }
#undef PG8_SA
#undef PG8_SB
#undef PG8_STAGE
#undef PG8_LDA
#undef PG8_LDB
#undef PG8_MMA
#undef PG8_WAIT_V
#undef PG8_WAIT_L
#undef PG8_BAR
#undef PG8_SCHED
}
}

namespace att {
typedef short bf16x8 __attribute__((ext_vector_type(8)));
typedef short s16x4 __attribute__((ext_vector_type(4)));
typedef float f32x4 __attribute__((ext_vector_type(4)));
typedef unsigned u32x4 __attribute__((ext_vector_type(4)));
#define ATT_LAS __attribute__((address_space(3)))
constexpr int KSTR = 144, VSTR = 136;
constexpr int KBUF = 64 * KSTR, VBUF = 64 * VSTR, SLOT = KBUF + VBUF;
constexpr int OFF_IMP = 2 * SLOT, IMP_LD = 257, OFF_SEL = OFF_IMP + 64 * IMP_LD * 4, LDS_BYTES = OFF_SEL + 64 * 8 * 4;

struct Stage { uint4 k, v; };
__device__ __forceinline__ void stage_load(Stage& r, const bf16_t* kbase, const bf16_t* vbase, size_t stride, int tid) {
    const int key = tid >> 3, c8 = (tid & 7) * 8;
    r.k = *(const uint4*)(kbase + (size_t)key * stride + c8); r.v = *(const uint4*)(vbase + (size_t)key * stride + c8);
}
__device__ __forceinline__ void stage_write(const Stage& r, ATT_LAS unsigned char* slot, int tid) {
    const int key = tid >> 3, c8 = (tid & 7) * 8;
    *(ATT_LAS u32x4*)(slot + key * KSTR + c8 * 2) = (u32x4){r.k.x, r.k.y, r.k.z, r.k.w};
    ATT_LAS unsigned short* vt = (ATT_LAS unsigned short*)(slot + KBUF) + key;
    constexpr int VS = VSTR / 2;
    vt[(c8 + 0) * VS] = (unsigned short)(r.v.x & 0xffff); vt[(c8 + 1) * VS] = (unsigned short)(r.v.x >> 16);
    vt[(c8 + 2) * VS] = (unsigned short)(r.v.y & 0xffff); vt[(c8 + 3) * VS] = (unsigned short)(r.v.y >> 16);
    vt[(c8 + 4) * VS] = (unsigned short)(r.v.z & 0xffff); vt[(c8 + 5) * VS] = (unsigned short)(r.v.z >> 16);
    vt[(c8 + 6) * VS] = (unsigned short)(r.v.w & 0xffff); vt[(c8 + 7) * VS] = (unsigned short)(r.v.w >> 16);
}
__device__ __forceinline__ unsigned pk_bf16(float lo, float hi) { return f2bf(lo) | (f2bf(hi) << 16); }

template <int MODE>
__device__ __forceinline__ void block_compute(const ATT_LAS unsigned char* slot, const bf16x8 (&qf)[2][2], f32x4 (&O)[2][4], float (&l)[2], const int (&hi)[2], const int (&lo)[2],
                                              const float (&pscale)[2], ATT_LAS float* imp_row0, ATT_LAS float* imp_row1, int jb, int lane) {
    const int col16 = lane & 15, q4 = lane >> 4;
#pragma unroll
    for (int ks = 0; ks < 2; ++ks) {
        bf16x8 kf[2][2];
#pragma unroll
        for (int kt = 0; kt < 2; ++kt)
#pragma unroll
            for (int st = 0; st < 2; ++st) kf[kt][st] = *(const ATT_LAS bf16x8*)(slot + (16 * (2 * ks + kt) + col16) * KSTR + st * 64 + q4 * 16);
        bf16x8 vf[4];
        if (MODE != 0) {
#pragma unroll
            for (int dt = 0; dt < 4; ++dt) { const ATT_LAS unsigned char* vp = slot + KBUF + (16 * dt + col16) * VSTR + (32 * ks + 4 * q4) * 2;
                const s16x4 a = *(const ATT_LAS s16x4*)vp, b = *(const ATT_LAS s16x4*)(vp + 32);
                vf[dt] = (bf16x8){a[0], a[1], a[2], a[3], b[0], b[1], b[2], b[3]}; }
        }
#pragma unroll
        for (int cg = 0; cg < 2; ++cg) {
            f32x4 s0 = {0.f, 0.f, 0.f, 0.f}, s1 = {0.f, 0.f, 0.f, 0.f};
            s0 = __builtin_amdgcn_mfma_f32_16x16x32_bf16(kf[0][0], qf[cg][0], s0, 0, 0, 0);
            s0 = __builtin_amdgcn_mfma_f32_16x16x32_bf16(kf[0][1], qf[cg][1], s0, 0, 0, 0);
            s1 = __builtin_amdgcn_mfma_f32_16x16x32_bf16(kf[1][0], qf[cg][0], s1, 0, 0, 0);
            s1 = __builtin_amdgcn_mfma_f32_16x16x32_bf16(kf[1][1], qf[cg][1], s1, 0, 0, 0);
            const int kk0 = 32 * ks + 4 * q4;
            float p0[4], p1[4];
#pragma unroll
            for (int r = 0; r < 4; ++r) {
                const int ka = kk0 + r, kb = kk0 + 16 + r;
                p0[r] = (ka <= hi[cg] && ka > lo[cg]) ? __builtin_amdgcn_exp2f(s0[r]) : 0.f;
                p1[r] = (kb <= hi[cg] && kb > lo[cg]) ? __builtin_amdgcn_exp2f(s1[r]) : 0.f;
            }
            if (MODE == 1) {
#pragma unroll
                for (int r = 0; r < 4; ++r) { p0[r] *= pscale[cg]; p1[r] *= pscale[cg]; }
                float w0 = (p0[0] + p0[1]) + (p0[2] + p0[3]), c0 = p0[3], w1 = (p1[0] + p1[1]) + (p1[2] + p1[3]), c1 = p1[3];
                w0 += __shfl_xor(w0, 1); w0 += __shfl_xor(w0, 2); c0 += __shfl_xor(c0, 1); c0 += __shfl_xor(c0, 2);
                w1 += __shfl_xor(w1, 1); w1 += __shfl_xor(w1, 2); c1 += __shfl_xor(c1, 1); c1 += __shfl_xor(c1, 2);
                if ((col16 & 3) == 0) { ATT_LAS float* ir = (cg == 0 ? imp_row0 : imp_row1) + jb + 8 * ks + q4;
                    __hip_atomic_fetch_add(ir, w0, __ATOMIC_RELAXED, __HIP_MEMORY_SCOPE_WORKGROUP); __hip_atomic_fetch_add(ir + 4, w1, __ATOMIC_RELAXED, __HIP_MEMORY_SCOPE_WORKGROUP);
                    __hip_atomic_fetch_add(ir + 1, c0, __ATOMIC_RELAXED, __HIP_MEMORY_SCOPE_WORKGROUP); __hip_atomic_fetch_add(ir + 5, c1, __ATOMIC_RELAXED, __HIP_MEMORY_SCOPE_WORKGROUP); }
            } else {
                l[cg] += ((p0[0] + p0[1]) + (p0[2] + p0[3])) + ((p1[0] + p1[1]) + (p1[2] + p1[3]));
            }
            if (MODE != 0) {
                union { bf16x8 v; unsigned u[4]; } pf;
                pf.u[0] = pk_bf16(p0[0], p0[1]); pf.u[1] = pk_bf16(p0[2], p0[3]); pf.u[2] = pk_bf16(p1[0], p1[1]); pf.u[3] = pk_bf16(p1[2], p1[3]);
#pragma unroll
                for (int dt = 0; dt < 4; ++dt) O[cg][dt] = __builtin_amdgcn_mfma_f32_16x16x32_bf16(vf[dt], pf.v, O[cg][dt], 0, 0, 0);
            }
        }
    }
}

struct Tensors { const bf16_t* Z; const bf16_t* KC; const bf16_t* VC; const float* gates; float* YATT; };

__device__ __forceinline__ void attn_item(ATT_LAS unsigned char* lds, const Tensors& T, int b, int h, int tile) {
    int tid = threadIdx.x; asm volatile("" : "+v"(tid));
    const int lane = tid & 63, wv = tid >> 6, col16 = lane & 15, q4 = lane >> 4, g = col16 & 3;
    const int t0 = tile * 64, cur = tile, bh = b * 2 + h;
    ATT_LAS float* imp = (ATT_LAS float*)(lds + OFF_IMP); ATT_LAS unsigned* sel = (ATT_LAS unsigned*)(lds + OFF_SEL);
    int tq[2]; size_t mrow[2];
#pragma unroll
    for (int cg = 0; cg < 2; ++cg) { tq[cg] = wv * 8 + cg * 4 + (col16 >> 2); mrow[cg] = (size_t)b * SEQ + t0 + tq[cg]; }
    const int hq = h * 4 + g;
    bf16x8 qf[2][2];
#pragma unroll
    for (int cg = 0; cg < 2; ++cg)
#pragma unroll
        for (int st = 0; st < 2; ++st) qf[cg][st] = *(const bf16x8*)(T.Z + mrow[cg] * NZ + hq * 64 + st * 32 + q4 * 8);
    __syncthreads();
    for (int e = tid; e < 64 * IMP_LD; e += 512) imp[e] = 0.f;
    for (int e = tid; e < 64 * 8; e += 512) sel[e] = 0u;
    f32x4 OT[2][4];
#pragma unroll
    for (int cg = 0; cg < 2; ++cg)
#pragma unroll
        for (int dt = 0; dt < 4; ++dt) OT[cg][dt] = (f32x4){0.f, 0.f, 0.f, 0.f};
    float l[2]; int hi[2], lo[2]; float psc[2] = {1.f, 1.f};
    ATT_LAS float* imp0 = imp + tq[0] * IMP_LD; ATT_LAS float* imp1 = imp + tq[1] * IMP_LD;
    Stage sr;
    const int nk = min(NC, t0 / 16 + 3), nch = (nk + 63) >> 6;
    const bf16_t* kcb = T.KC + (size_t)bh * 1024 * 64; const bf16_t* vcb = T.VC + (size_t)bh * 1024 * 64;
    int nmax[2];
#pragma unroll
    for (int cg = 0; cg < 2; ++cg) nmax[cg] = (t0 + tq[cg] - 31) >> 4;
    l[0] = 0.f; l[1] = 0.f; lo[0] = -1; lo[1] = -1;
    for (int pass = 0; pass < 2; ++pass) {
        if (pass == 1) {
#pragma unroll
            for (int cg = 0; cg < 2; ++cg) { float lt = l[cg]; lt += __shfl_xor(lt, 16); lt += __shfl_xor(lt, 32); psc[cg] = lt > 0.f ? 1.f / lt : 0.f; }
        }
        stage_load(sr, kcb, vcb, 64, tid);
        for (int c = 0; c < nch; ++c) {
            ATT_LAS unsigned char* slot = lds + (c & 1) * SLOT;
            stage_write(sr, slot, tid);
            if (c + 1 < nch) stage_load(sr, kcb + (size_t)(c + 1) * 64 * 64, vcb + (size_t)(c + 1) * 64 * 64, 64, tid);
            __syncthreads();
            hi[0] = nmax[0] - 64 * c; hi[1] = nmax[1] - 64 * c;
            if (pass == 0) block_compute<0>(slot, qf, OT, l, hi, lo, psc, imp0, imp1, 16 * c, lane);
            else block_compute<1>(slot, qf, OT, l, hi, lo, psc, imp0, imp1, 16 * c, lane);
        }
        __syncthreads();
    }
#pragma unroll
    for (int cg = 0; cg < 2; ++cg)
#pragma unroll
        for (int dt = 0; dt < 4; ++dt) OT[cg][dt] = OT[cg][dt] * T.gates[mrow[cg] * 24 + hq * 3 + 0];
    {
        const int q = tid >> 3, sub = tid & 7;
        if (cur + 1 <= 16) { if (sub == 0) sel[q * 8] = (1u << (cur + 1)) - 1u; }
        else {
            if (sub == 0) { sel[q * 8] |= 1u; sel[q * 8 + (cur >> 5)] |= 1u << (cur & 31); sel[q * 8 + ((cur - 1) >> 5)] |= 1u << ((cur - 1) & 31); }
#pragma unroll 1
            for (int it = 0; it < 13; ++it) {
                __syncthreads();
                float best = -1.f; int bj = 0x7fffffff;
                for (int j = 1 + sub; j <= cur - 2; j += 8) { const float v = imp[q * IMP_LD + j]; if (v > best) { best = v; bj = j; } }
#pragma unroll
                for (int off = 1; off <= 4; off <<= 1) { const float ob = __shfl_xor(best, off); const int oj = __shfl_xor(bj, off); if (ob > best || (ob == best && oj < bj)) { best = ob; bj = oj; } }
                if (sub == 0 && bj <= cur - 2) { imp[q * IMP_LD + bj] = -2.f; sel[q * 8 + (bj >> 5)] |= 1u << (bj & 31); }
            }
        }
    }
    __syncthreads();
    ATT_LAS f32x4* stash = (ATT_LAS f32x4*)(lds + OFF_IMP) + tid;
#pragma unroll
    for (int cg = 0; cg < 2; ++cg)
#pragma unroll
        for (int dt = 0; dt < 4; ++dt) stash[(cg * 4 + dt) * 512] = OT[cg][dt];
    const bf16_t* zb = T.Z + (size_t)b * SEQ * NZ + ZKV + h * 64;
#define O OT
    {
        l[0] = 0.f; l[1] = 0.f; lo[0] = -1; lo[1] = -1;
#pragma unroll
        for (int cg = 0; cg < 2; ++cg)
#pragma unroll
            for (int dt = 0; dt < 4; ++dt) O[cg][dt] = (f32x4){0.f, 0.f, 0.f, 0.f};
        stage_load(sr, zb + 2 * 128, zb + 3 * 128, NZ, tid);
        unsigned sw[2] = {0u, 0u};
        for (int j = 0; j <= cur; ++j) {
            ATT_LAS unsigned char* slot = lds + (j & 1) * SLOT;
            stage_write(sr, slot, tid);
            if (j + 1 <= cur) stage_load(sr, zb + (size_t)(j + 1) * 64 * NZ + 2 * 128, zb + (size_t)(j + 1) * 64 * NZ + 3 * 128, NZ, tid);
            __syncthreads();
            if ((j & 31) == 0) { sw[0] = sel[tq[0] * 8 + (j >> 5)]; sw[1] = sel[tq[1] * 8 + (j >> 5)]; }
#pragma unroll
            for (int cg = 0; cg < 2; ++cg) hi[cg] = ((sw[cg] >> (j & 31)) & 1u) ? (j == cur ? tq[cg] : 63) : -1;
            if (__any(hi[0] >= 0 || hi[1] >= 0)) block_compute<2>(slot, qf, O, l, hi, lo, psc, imp0, imp1, 0, lane);
        }
        __syncthreads();
#pragma unroll
        for (int cg = 0; cg < 2; ++cg) { float lt = l[cg]; lt += __shfl_xor(lt, 16); lt += __shfl_xor(lt, 32); const float sc = T.gates[mrow[cg] * 24 + hq * 3 + 1] / lt;
#pragma unroll
            for (int dt = 0; dt < 4; ++dt) stash[(cg * 4 + dt) * 512] = stash[(cg * 4 + dt) * 512] + O[cg][dt] * sc; }
    }
    {
        l[0] = 0.f; l[1] = 0.f;
#pragma unroll
        for (int cg = 0; cg < 2; ++cg)
#pragma unroll
            for (int dt = 0; dt < 4; ++dt) O[cg][dt] = (f32x4){0.f, 0.f, 0.f, 0.f};
        const int j0 = max(0, cur - 8);
        stage_load(sr, zb + (size_t)j0 * 64 * NZ + 4 * 128, zb + (size_t)j0 * 64 * NZ + 5 * 128, NZ, tid);
        for (int j = j0; j <= cur; ++j) {
            ATT_LAS unsigned char* slot = lds + (j & 1) * SLOT;
            stage_write(sr, slot, tid);
            if (j + 1 <= cur) stage_load(sr, zb + (size_t)(j + 1) * 64 * NZ + 4 * 128, zb + (size_t)(j + 1) * 64 * NZ + 5 * 128, NZ, tid);
            __syncthreads();
#pragma unroll
            for (int cg = 0; cg < 2; ++cg) { hi[cg] = (j == cur) ? tq[cg] : 63; lo[cg] = (j == cur - 8) ? tq[cg] : -1; }
            block_compute<2>(slot, qf, O, l, hi, lo, psc, imp0, imp1, 0, lane);
        }
#pragma unroll
        for (int cg = 0; cg < 2; ++cg) { float lt = l[cg]; lt += __shfl_xor(lt, 16); lt += __shfl_xor(lt, 32); const float sc = T.gates[mrow[cg] * 24 + hq * 3 + 2] / lt;
#pragma unroll
            for (int dt = 0; dt < 4; ++dt) *(f32x4*)(T.YATT + mrow[cg] * 512 + hq * 64 + 16 * dt + 4 * q4) = stash[(cg * 4 + dt) * 512] + O[cg][dt] * sc; }
    }
#undef O
}
}


#define LAS3 __attribute__((address_space(3)))

struct TrJob { const float* W; bf16_t* WT; int K, ldw, col_off, row_off, ntx, nty; };
__device__ __forceinline__ void ph_transpose_tile(const TrJob& J, int tile, LAS3 float* t  , int tid256, bool valid) {
    const int bx = tile % J.ntx, by = tile / J.ntx;
    const int n0 = bx * 32, k0 = by * 32, tx = tid256 & 31, ty = tid256 >> 5;
    if (valid) for (int i = ty; i < 32; i += 8) t[i * 33 + tx] = J.W[(size_t)(k0 + i) * J.ldw + J.col_off + n0 + tx];
    __syncthreads();
    if (valid) for (int i = ty; i < 32; i += 8) J.WT[(size_t)(J.row_off + n0 + i) * J.K + k0 + tx] = (bf16_t)f2bf(t[tx * 33 + i]);
    __syncthreads();
}
__device__ __forceinline__ void ph_transpose(const TrJob& J, LAS3 unsigned char* lds) {
    int tid_ = threadIdx.x; asm volatile("" : "+v"(tid_)); const int tid = tid_, sub = tid >> 8, tid256 = tid & 255; const int ntile = J.ntx * J.nty;
    LAS3 float* t = (LAS3 float*)lds + sub * (32 * 33);
    for (int base = blockIdx.x * 2; base < ntile; base += gridDim.x * 2) { const int tile = base + sub; ph_transpose_tile(J, tile < ntile ? tile : 0, t, tid256, tile < ntile); }
}

__device__ __forceinline__ void ph_rmsnorm(const float* __restrict__ x, const float* __restrict__ gamma, bf16_t* __restrict__ xn, float* __restrict__ rstd) {
    int tid_ = threadIdx.x; asm volatile("" : "+v"(tid_)); const int lane = tid_ & 63, wv = tid_ >> 6;
    for (int row = blockIdx.x * 8 + wv; row < MTOK; row += gridDim.x * 8) {
        const float4* xr = (const float4*)(x + (size_t)row * D_MODEL) + lane;
        float4 v[4]; float s = 0.f;
#pragma unroll
        for (int j = 0; j < 4; ++j) { v[j] = xr[64 * j]; s += (v[j].x * v[j].x + v[j].y * v[j].y) + (v[j].z * v[j].z + v[j].w * v[j].w); }
        const float r = rsqrtf(wave_sum(s) * (1.f / D_MODEL) + 1e-6f);
        if (lane == 0) rstd[row] = r;
        uint2* o = (uint2*)(xn + (size_t)row * D_MODEL) + lane;
#pragma unroll
        for (int j = 0; j < 4; ++j) { const float4 g = ((const float4*)gamma)[lane + 64 * j];
            uint2 w; w.x = f2bf(v[j].x * r * g.x) | (f2bf(v[j].y * r * g.y) << 16); w.y = f2bf(v[j].z * r * g.z) | (f2bf(v[j].w * r * g.w) << 16); o[64 * j] = w; }
    }
}
__device__ __forceinline__ void ph_gates(const float* __restrict__ x, const float* __restrict__ gamma, const float* __restrict__ w_in, float* __restrict__ gates) {
    int tid_ = threadIdx.x; asm volatile("" : "+v"(tid_)); const int tid = tid_; if (tid >= 384) return;
    const int j = tid % 24, slot = tid / 24;
    for (int m0 = blockIdx.x * 64 + slot * 4; m0 < MTOK; m0 += gridDim.x * 64) {
        float a0 = 0.f, a1 = 0.f, a2 = 0.f, a3 = 0.f, q0 = 0.f, q1 = 0.f, q2 = 0.f, q3 = 0.f;
        const float* x0 = x + (size_t)m0 * D_MODEL;
        for (int k = 0; k < D_MODEL; ++k) { const float w = w_in[(size_t)k * N_IN + OFF_GATE_SRC + j] * gamma[k];
            const float v0 = x0[k], v1 = x0[D_MODEL + k], v2 = x0[2 * D_MODEL + k], v3 = x0[3 * D_MODEL + k];
            a0 += v0 * w; a1 += v1 * w; a2 += v2 * w; a3 += v3 * w; q0 += v0 * v0; q1 += v1 * v1; q2 += v2 * v2; q3 += v3 * v3; }
        gates[(size_t)(m0 + 0) * 24 + j] = sigmoidf_(a0 * rsqrtf(q0 * (1.f / D_MODEL) + 1e-6f)); gates[(size_t)(m0 + 1) * 24 + j] = sigmoidf_(a1 * rsqrtf(q1 * (1.f / D_MODEL) + 1e-6f));
        gates[(size_t)(m0 + 2) * 24 + j] = sigmoidf_(a2 * rsqrtf(q2 * (1.f / D_MODEL) + 1e-6f)); gates[(size_t)(m0 + 3) * 24 + j] = sigmoidf_(a3 * rsqrtf(q3 * (1.f / D_MODEL) + 1e-6f));
    }
}
__device__ __forceinline__ void ph_qknorm(bf16_t* __restrict__ Z, const float* __restrict__ qn, const float* __restrict__ kn) {
    int tid_ = threadIdx.x; asm volatile("" : "+v"(tid_)); const int lane = tid_ & 63, wv = tid_ >> 6, sub = lane >> 4, e = (lane & 15) * 4;
    for (int m = blockIdx.x * 8 + wv; m < MTOK; m += gridDim.x * 8) {
#pragma unroll
        for (int p = 0; p < 3; ++p) {
            const int v = p * 4 + sub;
            const int col = v < 8 ? v * 64 : (v < 10 ? ZKV + 2 * 128 + (v - 8) * 64 : ZKV + 4 * 128 + (v - 10) * 64);
            const float* gm = v < 8 ? qn : (v < 10 ? kn + 64 : kn + 128);
            const float sc = v < 8 ? 0.125f * 1.4426950408889634f : 1.f;
            uint2* ptr = (uint2*)(Z + (size_t)m * NZ + col + e);
            const uint2 w = *ptr;
            const float a = bf2f(w.x & 0xffff), b = bf2f(w.x >> 16), c = bf2f(w.y & 0xffff), d = bf2f(w.y >> 16);
            float s = a * a + b * b + c * c + d * d;
            s += __shfl_xor(s, 1); s += __shfl_xor(s, 2); s += __shfl_xor(s, 4); s += __shfl_xor(s, 8);
            const float r = rsqrtf(s * (1.f / 64.f) + 1e-6f) * sc;
            uint2 o; o.x = f2bf(a * r * gm[e]) | (f2bf(b * r * gm[e + 1]) << 16); o.y = f2bf(c * r * gm[e + 2]) | (f2bf(d * r * gm[e + 3]) << 16);
            *ptr = o;
        }
    }
}

struct CmpArgs { const bf16_t* Z; const float* pos; const float* w1; const float* w2; const float* kn0; bf16_t* KC; bf16_t* VC; };
__device__ __forceinline__ void ph_compress(const CmpArgs& A, LAS3 unsigned char* lds) {
    int tid_ = threadIdx.x; asm volatile("" : "+v"(tid_)); const int sub = tid_ >> 7, tid = tid_ & 127;
    LAS3 unsigned short* zs = (LAS3 unsigned short*)(lds + sub * 22528); LAS3 float* hid = (LAS3 float*)(lds + sub * 22528 + 18432);
    for (int it0 = blockIdx.x * 4; it0 < 1024; it0 += gridDim.x * 4) {
        const int item = it0 + sub, kv = item >> 9, bx = item & 511, bh = bx >> 7, ig = bx & 127, b = bh >> 1, h = bh & 1, i0 = ig * 8;
        const int col = ZKV + kv * 128 + h * 64;
        __syncthreads();
        for (int e = tid; e < 144 * 8; e += 128) { const int tt = e >> 3, c8 = (e & 7) * 8; const int tok = 16 * i0 + tt;
            uint4 w = make_uint4(0u, 0u, 0u, 0u); if (tok < SEQ) w = *(const uint4*)(A.Z + (size_t)(b * SEQ + tok) * NZ + col + c8);
            LAS3 unsigned* d = (LAS3 unsigned*)(zs + tt * 64 + c8); d[0] = w.x; d[1] = w.y; d[2] = w.z; d[3] = w.w; }
        __syncthreads();
        const float* W1 = A.w1 + (size_t)kv * 2048 * 128; const float* P = A.pos + kv * 2048;
        float acc[8]; float cb = 0.f;
#pragma unroll
        for (int r = 0; r < 8; ++r) acc[r] = 0.f;
        for (int l = 0; l < 32; ++l)
            for (int d = 0; d < 64; ++d) { const float w = W1[(size_t)(l * 64 + d) * 128 + tid]; cb += P[l * 64 + d] * w;
#pragma unroll
                for (int r = 0; r < 8; ++r) acc[r] += bf2f(zs[(16 * r + l) * 64 + d]) * w; }
#pragma unroll
        for (int r = 0; r < 8; ++r) hid[r * 128 + tid] = gelu_tanh(acc[r] + cb);
        __syncthreads();
        const int c = tid & 63, half = tid >> 6; const float* W2 = A.w2 + kv * 128 * 64;
        float o[4] = {0.f, 0.f, 0.f, 0.f};
        for (int j = 0; j < 128; ++j) { const float w = W2[j * 64 + c];
#pragma unroll
            for (int r = 0; r < 4; ++r) o[r] += hid[(half * 4 + r) * 128 + j] * w; }
#pragma unroll
        for (int r = 0; r < 4; ++r) { const int i = i0 + half * 4 + r; float val = o[r];
            const float ss = wave_sum(val * val); if (kv == 0) val = val * rsqrtf(ss * (1.f / 64.f) + 1e-6f) * A.kn0[c];
            bf16_t* dst = (kv == 0 ? A.KC : A.VC) + ((size_t)bh * 1024 + i) * 64 + c; *dst = (bf16_t)f2bf(i < NC ? val : 0.f); }
    }
}

struct LruArgs { const bf16_t* Z; const float* cw; const float* cbias; const float* wa; const float* ba; const float* wx; const float* bx; const float* lam; float* Hloc; float* Pc; float* SP; float* SH; float* CIN; };
__device__ __forceinline__ void ph_lru1(const LruArgs& A, LAS3 unsigned char* lds) {
    int tid_ = threadIdx.x; asm volatile("" : "+v"(tid_)); const int sub = tid_ >> 8, c = tid_ & 255;
    LAS3 float* xs = (LAS3 float*)(lds + sub * 32768);
    for (int it0 = blockIdx.x * 2; it0 < 1024; it0 += gridDim.x * 2) {
        const int item = it0 + sub, chunk = item & 511, b = item >> 9, t0 = chunk * 32;
        const float w0 = A.cw[c], w1 = A.cw[256 + c], w2 = A.cw[512 + c], w3 = A.cw[768 + c], bb = A.cbias[c];
        const bf16_t* zx = A.Z + (size_t)(b * SEQ) * NZ + ZLX + c;
        float xm3 = t0 >= 3 ? bf2f(zx[(size_t)(t0 - 3) * NZ]) : 0.f, xm2 = t0 >= 2 ? bf2f(zx[(size_t)(t0 - 2) * NZ]) : 0.f, xm1 = t0 >= 1 ? bf2f(zx[(size_t)(t0 - 1) * NZ]) : 0.f;
        __syncthreads();
        for (int tt = 0; tt < 32; ++tt) { const float x0 = bf2f(zx[(size_t)(t0 + tt) * NZ]);
            xs[tt * 256 + c] = bb + w0 * xm3 + w1 * xm2 + w2 * xm1 + w3 * x0; xm3 = xm2; xm2 = xm1; xm1 = x0; }
        __syncthreads();
        const int hh = c >> 5, j = c & 31;
        float war[32], wxr[32];
#pragma unroll
        for (int i = 0; i < 32; ++i) { war[i] = A.wa[(hh * 32 + i) * 32 + j]; wxr[i] = A.wx[(hh * 32 + i) * 32 + j]; }
        const float bac = A.ba[c], bxc = A.bx[c]; const float sp = log1pf(expf(-A.lam[c]));
        float hst = 0.f, pr = 1.f;
        for (int tt = 0; tt < 32; ++tt) {
            float ra = 0.f, rx = 0.f;
#pragma unroll
            for (int i = 0; i < 32; ++i) { const float xv = xs[tt * 256 + hh * 32 + i]; ra += xv * war[i]; rx += xv * wxr[i]; }
            const float r = sigmoidf_(ra + bac), ig = sigmoidf_(rx + bxc);
            const float log_a = -8.f * r * sp, a = expf(log_a), mult = sqrtf(-expm1f(2.f * log_a));
            const float u = xs[tt * 256 + c] * ig * mult;
            hst = a * hst + u; pr *= a;
            const size_t o = (size_t)(b * SEQ + t0 + tt) * 256 + c; A.Hloc[o] = hst; A.Pc[o] = pr; }
        A.SP[(size_t)(b * 512 + chunk) * 256 + c] = pr; A.SH[(size_t)(b * 512 + chunk) * 256 + c] = hst;
    }
}
__device__ __forceinline__ void ph_lru2(const LruArgs& A) {
    int tid_ = threadIdx.x; asm volatile("" : "+v"(tid_)); const int c = tid_ & 255, b = tid_ >> 8; float run = 0.f;
    for (int ch = 0; ch < 512; ++ch) { const size_t o = (size_t)(b * 512 + ch) * 256 + c; A.CIN[o] = run; run = A.SP[o] * run + A.SH[o]; }
}

struct ConvArgs { const bf16_t* Z; const float* dw; const float* dwb; const float* lng; const float* lnb; float* YCV; };
__device__ __forceinline__ void ph_conv(const ConvArgs& A, LAS3 unsigned char* lds) {
    int tid_ = threadIdx.x; asm volatile("" : "+v"(tid_)); const int sub = tid_ >> 8, c = tid_ & 255, wv = c >> 6;
    LAS3 float* gl = (LAS3 float*)(lds + sub * 47360); LAS3 float* red = (LAS3 float*)(lds + sub * 47360 + 47104);
    for (int it0 = blockIdx.x * 2; it0 < 2048; it0 += gridDim.x * 2) {
        const int item = it0 + sub, chunk = item & 1023, b = item >> 10, t0 = chunk * 16;
        __syncthreads();
        for (int tt = 0; tt < 46; ++tt) { const int t = t0 - 30 + tt; float v = 0.f;
            if (t >= 0) { const bf16_t* zr = A.Z + (size_t)(b * SEQ + t) * NZ + ZCV; v = bf2f(zr[c]) * sigmoidf_(bf2f(zr[256 + c])); }
            gl[tt * 256 + c] = v; }
        __syncthreads();
        float y[16]; const float bias = A.dwb[c];
#pragma unroll
        for (int tt = 0; tt < 16; ++tt) y[tt] = bias;
        for (int k = 0; k < 31; ++k) { const float w = A.dw[k * 256 + c];
#pragma unroll
            for (int tt = 0; tt < 16; ++tt) y[tt] += w * gl[(tt + k) * 256 + c]; }
#pragma unroll
        for (int tt = 0; tt < 16; ++tt) { const float s = wave_sum(y[tt]); if ((c & 63) == 0) red[tt * 4 + wv] = s; }
        __syncthreads();
        float mu[16];
#pragma unroll
        for (int tt = 0; tt < 16; ++tt) mu[tt] = (red[tt * 4] + red[tt * 4 + 1] + red[tt * 4 + 2] + red[tt * 4 + 3]) * (1.f / 256.f);
        __syncthreads();
#pragma unroll
        for (int tt = 0; tt < 16; ++tt) { const float d = y[tt] - mu[tt]; const float s = wave_sum(d * d); if ((c & 63) == 0) red[tt * 4 + wv] = s; }
        __syncthreads();
        const float g = A.lng[c], bt = A.lnb[c];
#pragma unroll
        for (int tt = 0; tt < 16; ++tt) { const float var = (red[tt * 4] + red[tt * 4 + 1] + red[tt * 4 + 2] + red[tt * 4 + 3]) * (1.f / 256.f);
            const float v = (y[tt] - mu[tt]) * rsqrtf(var + 1e-6f) * g + bt;
            A.YCV[(size_t)(b * SEQ + t0 + tt) * 256 + c] = v * sigmoidf_(v); }
    }
}

struct GnArgs { const float* YATT; const float* Hloc; const float* Pc; const float* CIN; const bf16_t* Z; const float* YCV; const float* gout; bf16_t* Y; };
__device__ __forceinline__ void ph_groupnorm(const GnArgs& A) {
    int tid_ = threadIdx.x; asm volatile("" : "+v"(tid_)); const int lane = tid_ & 63, wv = tid_ >> 6;
    for (int m = blockIdx.x * 8 + wv; m < MTOK; m += gridDim.x * 8) {
        const int b = m / SEQ, t = m % SEQ;
        const float4* ya = (const float4*)(A.YATT + (size_t)m * 512) + lane * 2;
        const float4 a0 = ya[0], a1 = ya[1];
        float s = (a0.x * a0.x + a0.y * a0.y) + (a0.z * a0.z + a0.w * a0.w) + (a1.x * a1.x + a1.y * a1.y) + (a1.z * a1.z + a1.w * a1.w);
        const float ra = rsqrtf(wave_sum(s) * (1.f / 512.f) + 1e-6f);
        { const float* g = A.gout + lane * 8; uint4 w;
          w.x = f2bf(a0.x * ra * g[0]) | (f2bf(a0.y * ra * g[1]) << 16); w.y = f2bf(a0.z * ra * g[2]) | (f2bf(a0.w * ra * g[3]) << 16);
          w.z = f2bf(a1.x * ra * g[4]) | (f2bf(a1.y * ra * g[5]) << 16); w.w = f2bf(a1.z * ra * g[6]) | (f2bf(a1.w * ra * g[7]) << 16);
          *((uint4*)(A.Y + (size_t)m * 1024) + lane) = w; }
        { const int c0 = lane * 4; const size_t o = (size_t)m * 256 + c0; const float4 hl = *(const float4*)(A.Hloc + o), pc = *(const float4*)(A.Pc + o);
          const float4 ci = *(const float4*)(A.CIN + (size_t)(b * 512 + (t >> 5)) * 256 + c0);
          const uint2 gz = *(const uint2*)(A.Z + (size_t)m * NZ + ZLG + c0);
          float y0 = (hl.x + pc.x * ci.x) * gelu_tanh(bf2f(gz.x & 0xffff)), y1 = (hl.y + pc.y * ci.y) * gelu_tanh(bf2f(gz.x >> 16));
          float y2 = (hl.z + pc.z * ci.z) * gelu_tanh(bf2f(gz.y & 0xffff)), y3 = (hl.w + pc.w * ci.w) * gelu_tanh(bf2f(gz.y >> 16));
          const float rl = rsqrtf(wave_sum(y0 * y0 + y1 * y1 + y2 * y2 + y3 * y3) * (1.f / 256.f) + 1e-6f);
          const float* g = A.gout + 512 + c0; uint2 w; w.x = f2bf(y0 * rl * g[0]) | (f2bf(y1 * rl * g[1]) << 16); w.y = f2bf(y2 * rl * g[2]) | (f2bf(y3 * rl * g[3]) << 16);
          *((uint2*)(A.Y + (size_t)m * 1024 + 512) + lane) = w; }
        { const int c0 = lane * 4; const float4 v = *(const float4*)(A.YCV + (size_t)m * 256 + c0);
          const float rc = rsqrtf(wave_sum(v.x * v.x + v.y * v.y + v.z * v.z + v.w * v.w) * (1.f / 256.f) + 1e-6f);
          const float* g = A.gout + 768 + c0; uint2 w; w.x = f2bf(v.x * rc * g[0]) | (f2bf(v.y * rc * g[1]) << 16); w.y = f2bf(v.z * rc * g[2]) | (f2bf(v.w * rc * g[3]) << 16);
          *((uint2*)(A.Y + (size_t)m * 1024 + 768) + lane) = w; }
    }
}

constexpr size_t MiB = 1u << 20;
constexpr size_t WS_WIN = 1 * MiB;
constexpr size_t WS_WOUT = 11 * MiB;
constexpr size_t WS_W1 = 15 * MiB;
constexpr size_t WS_W2 = 31 * MiB;
constexpr size_t WS_RSTD = 47 * MiB;
constexpr size_t WS_LRUS = 48 * MiB;
constexpr size_t WS_XN = 65 * MiB;
constexpr size_t WS_Z = 129 * MiB;
constexpr size_t WS_GATES = 273 * MiB;
constexpr size_t WS_KC = 276 * MiB, WS_VC = 277 * MiB;
constexpr size_t WS_YATT = 278 * MiB;
constexpr size_t WS_HLOC = 342 * MiB;
constexpr size_t WS_YCV = 374 * MiB;
constexpr size_t WS_Y = 406 * MiB;
constexpr size_t WS_PC = 470 * MiB;
constexpr size_t WS_H = 129 * MiB;
constexpr size_t WS_END = 502 * MiB;
constexpr int MEGA_LDS = 131072;

struct MegaParams { const float* in[24]; float* out; unsigned char* ws; };

__global__ void __launch_bounds__(512, 2) mega_fwd(MegaParams p) {
    extern __shared__ __attribute__((aligned(16))) unsigned char lds_raw[];
    LAS3 unsigned char* lds = (LAS3 unsigned char*)lds_raw;
    cg::grid_group grid = cg::this_grid();
    const float* x = p.in[0]; const float* attn_norm = p.in[1]; const float* w_in = p.in[2]; const float* q_norm = p.in[3];
    const float* k_norm = p.in[4]; const float* cmp_pos = p.in[5]; const float* cmp_w1 = p.in[6]; const float* cmp_w2 = p.in[7];
    const float* lru_conv_w = p.in[8]; const float* lru_conv_b = p.in[9]; const float* lru_wa = p.in[10]; const float* lru_ba = p.in[11];
    const float* lru_wx = p.in[12]; const float* lru_bx = p.in[13]; const float* lru_lambda = p.in[14]; const float* cv_dw_w = p.in[15];
    const float* cv_dw_b = p.in[16]; const float* cv_ln_g = p.in[17]; const float* cv_ln_b = p.in[18]; const float* out_norm = p.in[19];
    const float* w_out = p.in[20]; const float* mlp_norm = p.in[21]; const float* mlp_w1 = p.in[22]; const float* mlp_w2 = p.in[23];
    unsigned char* ws = p.ws; float* out = p.out;
    bf16_t* WinT = (bf16_t*)(ws + WS_WIN); bf16_t* WoutT = (bf16_t*)(ws + WS_WOUT); bf16_t* W1T = (bf16_t*)(ws + WS_W1); bf16_t* W2T = (bf16_t*)(ws + WS_W2);
    float* rstd = (float*)(ws + WS_RSTD); float* SP = (float*)(ws + WS_LRUS); float* SH = SP + 2 * 512 * 256; float* CIN = SH + 2 * 512 * 256;
    bf16_t* XN = (bf16_t*)(ws + WS_XN); bf16_t* Z = (bf16_t*)(ws + WS_Z); float* gates = (float*)(ws + WS_GATES); bf16_t* KC = (bf16_t*)(ws + WS_KC); bf16_t* VC = (bf16_t*)(ws + WS_VC);
    float* YATT = (float*)(ws + WS_YATT); float* HLOC = (float*)(ws + WS_HLOC); float* YCV = (float*)(ws + WS_YCV); bf16_t* Y = (bf16_t*)(ws + WS_Y); float* PC = (float*)(ws + WS_PC); bf16_t* H = (bf16_t*)(ws + WS_H);
    const int G = (int)gridDim.x, bid = (int)blockIdx.x;

    for (int l = 0; l < 2; ++l) {
        const float* wi = w_in + (size_t)l * D_MODEL * N_IN;
        { TrJob J{wi, WinT + (size_t)l * NZ * 1024, 1024, N_IN, 0, 0, 1280 / 32, 1024 / 32}; ph_transpose(J, lds); }
        { TrJob J{wi, WinT + (size_t)l * NZ * 1024, 1024, N_IN, OFF_LRU_SRC, 1280, 1024 / 32, 1024 / 32}; ph_transpose(J, lds); }
        { TrJob J{w_out + (size_t)l * 1024 * 1024, WoutT + (size_t)l * 1024 * 1024, 1024, 1024, 0, 0, 1024 / 32, 1024 / 32}; ph_transpose(J, lds); }
        { TrJob J{mlp_w1 + (size_t)l * 1024 * 4096, W1T + (size_t)l * 4096 * 1024, 1024, 4096, 0, 0, 4096 / 32, 1024 / 32}; ph_transpose(J, lds); }
        { TrJob J{mlp_w2 + (size_t)l * 4096 * 1024, W2T + (size_t)l * 1024 * 4096, 4096, 1024, 0, 0, 1024 / 32, 4096 / 32}; ph_transpose(J, lds); }
    }
    for (int l = 0; l < 2; ++l) {
        const float* xin = l == 0 ? x : out;
        ph_rmsnorm(xin, attn_norm + l * 1024, XN, rstd);
        ph_gates(xin, attn_norm + l * 1024, w_in + (size_t)l * D_MODEL * N_IN, gates);
        grid.sync();
        { pg8::Gemm g{XN, WinT + (size_t)l * NZ * 1024, MTOK, NZ, 1024, 0}; pg8::StaticOrder S; S.init(MTOK, NZ, G, bid); pg8::EpiBf16<0> E{Z, NZ, 0};
          pg8::gemm_phase<pg8::EpiBf16<0>, pg8::StaticOrder, true, true>(lds, g, S, E); }
        grid.sync();
        ph_qknorm(Z, q_norm + l * 64, k_norm + l * 192);
        { CmpArgs A{Z, cmp_pos + (size_t)l * 2 * 2048, cmp_w1 + (size_t)l * 2 * 2048 * 128, cmp_w2 + (size_t)l * 2 * 128 * 64, k_norm + l * 192, KC, VC}; ph_compress(A, lds); }
        LruArgs LA{Z, lru_conv_w + l * 1024, lru_conv_b + l * 256, lru_wa + l * 8192, lru_ba + l * 256, lru_wx + l * 8192, lru_bx + l * 256, lru_lambda + l * 256, HLOC, PC, SP, SH, CIN};
        ph_lru1(LA, lds);
        { ConvArgs A{Z, cv_dw_w + l * 31 * 256, cv_dw_b + l * 256, cv_ln_g + l * 256, cv_ln_b + l * 256, YCV}; ph_conv(A, lds); }
        grid.sync();
        if (bid == G - 1) ph_lru2(LA);
        { att::Tensors T{Z, KC, VC, gates, YATT};
          for (int c = bid; c < 256; c += G)
              for (int it = 0; it < 4; ++it) { const int tile = (it & 1) ? 255 - c : c; att::attn_item(lds, T, it >> 1, it & 1, tile); } }
        grid.sync();
        { GnArgs A{YATT, HLOC, PC, CIN, Z, YCV, out_norm + l * 1024, Y}; ph_groupnorm(A); }
        grid.sync();
        { pg8::Gemm g{Y, WoutT + (size_t)l * 1024 * 1024, MTOK, 1024, 1024, 0}; pg8::StaticOrder S; S.init(MTOK, 1024, G, bid); pg8::EpiResF32 E{xin, out, 1024, 0};
          pg8::gemm_phase<pg8::EpiResF32, pg8::StaticOrder, true, true>(lds, g, S, E); }
        grid.sync();
        ph_rmsnorm(out, mlp_norm + l * 1024, XN, rstd);
        grid.sync();
        { pg8::Gemm g{XN, W1T + (size_t)l * 4096 * 1024, MTOK, 4096, 1024, 0}; pg8::StaticOrder S; S.init(MTOK, 4096, G, bid); pg8::EpiBf16<2> E{H, 4096, 0};
          pg8::gemm_phase<pg8::EpiBf16<2>, pg8::StaticOrder, true, true>(lds, g, S, E); }
        grid.sync();
        { pg8::Gemm g{H, W2T + (size_t)l * 1024 * 4096, MTOK, 1024, 4096, 0}; pg8::StaticOrder S; S.init(MTOK, 1024, G, bid); pg8::EpiResF32 E{out, out, 1024, 0};
          pg8::gemm_phase<pg8::EpiResF32, pg8::StaticOrder, true, true>(lds, g, S, E); }
        if (l == 0) grid.sync();
    }
}

extern "C" void kernel_launch(void* const* d_in, const int* in_sizes, int n_in, void* d_out, int out_size, void* d_ws, size_t ws_size, hipStream_t stream) {
    if (n_in != 24 || in_sizes[0] != MTOK * D_MODEL || out_size != MTOK * D_MODEL || ws_size < WS_END) {
        fprintf(stderr, "kernel_launch: unexpected shapes: n_in %d in0 %d out %d ws %zu (need %zu)\n", n_in, n_in > 0 ? in_sizes[0] : -1, out_size, ws_size, (size_t)WS_END); return; }
    static int grid_blocks = 0;
    if (!grid_blocks) {
        int dev = 0, cus = 0, per_cu = 0;
        (void)hipGetDevice(&dev);
        (void)hipDeviceGetAttribute(&cus, hipDeviceAttributeMultiprocessorCount, dev);
        (void)hipFuncSetAttribute((const void*)mega_fwd, hipFuncAttributeMaxDynamicSharedMemorySize, MEGA_LDS);
        (void)hipOccupancyMaxActiveBlocksPerMultiprocessor(&per_cu, (const void*)mega_fwd, 512, MEGA_LDS);
        if (per_cu < 1) { fprintf(stderr, "kernel_launch: occupancy query returned %d\n", per_cu); per_cu = 1; }
        if (per_cu > 1) per_cu = 1;
        grid_blocks = cus * per_cu;
    }
    MegaParams p{};
    for (int i = 0; i < 24; ++i) p.in[i] = (const float*)d_in[i];
    p.out = (float*)d_out; p.ws = (unsigned char*)d_ws;
    void* args[] = {&p};
    hipError_t e = hipLaunchCooperativeKernel((const void*)mega_fwd, dim3(grid_blocks), dim3(512), args, MEGA_LDS, stream);
    if (e != hipSuccess) fprintf(stderr, "cooperative launch failed: %s (grid %d)\n", hipGetErrorString(e), grid_blocks);
}
```

```cpp
#include <hip/hip_runtime.h>
#include <hip/hip_cooperative_groups.h>
namespace cg = cooperative_groups;
#include <cstdio>
#include <cstdint>

constexpr int D_MODEL = 1024, BATCH = 2, SEQ = 16384, MTOK = BATCH * SEQ, N_IN = 2328, NZ = 2304, D_FF = 4096;
constexpr int ZQ = 0, ZKV = 512, ZLX = 1280, ZLG = 1536, ZCV = 1792;
constexpr int OFF_GATE_SRC = 1280, OFF_LRU_SRC = 1304;
constexpr int NC = 1023, NSLC = 256;
constexpr int NZP = 2560;

typedef unsigned short bf16_t;
constexpr int MEGA_CTL = 135168;
extern __shared__ __attribute__((aligned(16))) unsigned char g_lds_raw[];
__device__ __forceinline__ unsigned hw_wave_slot() { return (unsigned)__builtin_amdgcn_s_getreg(((6 - 1) << 11) | 4) & 63u; }
__device__ __forceinline__ int phase_tid() {
    const int wv = ((const __attribute__((address_space(3))) int*)((__attribute__((address_space(3))) unsigned char*)g_lds_raw + MEGA_CTL))[64 + hw_wave_slot()];
    int ln; asm volatile("v_mbcnt_lo_u32_b32 %0, -1, 0\n\tv_mbcnt_hi_u32_b32 %0, -1, %0" : "=v"(ln));
    int t = wv * 64 + ln;
    asm volatile("" : "+v"(t));
    return t;
}
__device__ __forceinline__ unsigned f2bf(float f) { unsigned u = __builtin_bit_cast(unsigned, f); return (u + 0x7fffu + ((u >> 16) & 1u)) >> 16; }
__device__ __forceinline__ float bf2f(unsigned short h) { return __builtin_bit_cast(float, (unsigned)h << 16); }
__device__ __forceinline__ float dpp_add(float v, const int ctrl_unused) { return v; }
__device__ __forceinline__ float row16_sum(float v) {
    v += __builtin_bit_cast(float, __builtin_amdgcn_update_dpp(0, __builtin_bit_cast(int, v), 0xB1, 0xF, 0xF, true));
    v += __builtin_bit_cast(float, __builtin_amdgcn_update_dpp(0, __builtin_bit_cast(int, v), 0x4E, 0xF, 0xF, true));
    v += __builtin_bit_cast(float, __builtin_amdgcn_update_dpp(0, __builtin_bit_cast(int, v), 0x141, 0xF, 0xF, true));
    v += __builtin_bit_cast(float, __builtin_amdgcn_update_dpp(0, __builtin_bit_cast(int, v), 0x140, 0xF, 0xF, true));
    return v;
}
__device__ __forceinline__ float wave_sum(float v) {
    v = row16_sum(v);
    const float a = __builtin_bit_cast(float, __builtin_amdgcn_readlane(__builtin_bit_cast(int, v), 0)), b = __builtin_bit_cast(float, __builtin_amdgcn_readlane(__builtin_bit_cast(int, v), 16));
    const float c = __builtin_bit_cast(float, __builtin_amdgcn_readlane(__builtin_bit_cast(int, v), 32)), d = __builtin_bit_cast(float, __builtin_amdgcn_readlane(__builtin_bit_cast(int, v), 48));
    return (a + b) + (c + d);
}
__device__ __forceinline__ float gelu_tanh(float x) { const float u = 0.7978845608028654f * (x + 0.044715f * x * x * x); return 0.5f * x * (1.f + tanhf(u)); }
__device__ __forceinline__ float sigmoidf_(float x) { return 1.f / (1.f + __expf(-x)); }

namespace pg8 {
#define PG8_LAS __attribute__((address_space(3)))
using ::bf16_t;
typedef short bf16x8 __attribute__((ext_vector_type(8)));
typedef float f32x4 __attribute__((ext_vector_type(4)));
typedef unsigned u32x4 __attribute__((ext_vector_type(4)));
constexpr int BM = 256, BK = 64, HALF = 128, HTB = HALF * BK * 2  , STAGE_BYTES = 8 * HTB, NXCD = 8, WGM = 8;

__host__ __device__ __forceinline__ int lds_byte(int r, int c) { const int st = (r >> 4) * 2 + (c >> 5), rr = r & 15, cc = c & 31, ob = rr * 64 + cc * 2; return st * 1024 + (ob ^ (((ob >> 9) & 1) << 5)); }
__host__ __device__ __forceinline__ void stage_rc(int b, int& R, int& C) { const int st = b / 1024, sb = b % 1024, swz = sb ^ (((sb >> 9) & 1) << 5); R = (st >> 1) * 16 + swz / 64; C = (st & 1) * 32 + (swz % 64) / 2; }
__host__ __device__ __forceinline__ int perm32(int rho) { const int n = rho >> 4, i = rho & 15; return 8 * (i >> 2) + 4 * n + (i & 3); }

struct Unit { int pm, pn; };
struct Gemm { const bf16_t* A; const bf16_t* Bt; int M, N, K, pad; };

struct StaticOrder {
    int nM, nN, nwg, G, c;
    __host__ __device__ void init(int M, int N, int G_, int c_) { nM = M / BM; nN = N / BM; nwg = nM * nN; G = G_; c = c_; }
    __host__ __device__ bool next(int i, Unit& u) const {
        const long L = (long)i * G + c; if (L >= nwg) return false;
        int wgid = (int)L; { const int q = nwg / NXCD, r = nwg % NXCD, xcd = wgid % NXCD, off = wgid / NXCD; wgid = (xcd < r ? xcd * (q + 1) : r * (q + 1) + (xcd - r) * q) + off; }
        const int nig = WGM * nN, gid = wgid / nig, fm = gid * WGM, gsz = (nM - fm) < WGM ? (nM - fm) : WGM;
        u.pm = fm + ((wgid % nig) % gsz); u.pn = (wgid % nig) / gsz; return true;
    }
    __device__ __forceinline__ void a_ready(const Unit&) const {}
    __device__ __forceinline__ void done(const Unit&) const {}
};


__device__ __forceinline__ unsigned cvt_pk_bf16(float lo, float hi) { unsigned r; asm volatile("v_cvt_pk_bf16_f32 %0, %1, %2" : "=v"(r) : "v"(lo), "v"(hi)); return r; }

template <int ACT  > struct EpiBf16 {
    static constexpr bool PERM = true, AFTER_DRAIN = false;
    bf16_t* O; int ldc, pad;
    __device__ __forceinline__ void operator()(const f32x4 (&acc)[2][2][4][2], const Unit& u, int wr, int wc, int fr, int fq) const {
        const int row0 = u.pm * BM + wr * 64 + fr; const int col0 = u.pn * BM + wc * 32 + 8 * fq;
#pragma unroll
        for (int ai = 0; ai < 2; ++ai)
#pragma unroll
            for (int m = 0; m < 4; ++m) { bf16_t* rowp = O + (size_t)(row0 + ai * HALF + m * 16) * ldc + col0;
#pragma unroll
                for (int bj = 0; bj < 2; ++bj) { f32x4 v0 = acc[ai][bj][m][0], v1 = acc[ai][bj][m][1];
                    if (ACT == 2) {
#pragma unroll
                        for (int e = 0; e < 4; ++e) { float a = v0[e] > 0.f ? v0[e] : 0.f; v0[e] = a * a; float b = v1[e] > 0.f ? v1[e] : 0.f; v1[e] = b * b; } }
                    u32x4 w; w.x = cvt_pk_bf16(v0[0], v0[1]); w.y = cvt_pk_bf16(v0[2], v0[3]); w.z = cvt_pk_bf16(v1[0], v1[1]); w.w = cvt_pk_bf16(v1[2], v1[3]);
                    *(u32x4*)(rowp + bj * HALF) = w; } }
    }
};
struct EpiResF32 {
    static constexpr bool PERM = false, AFTER_DRAIN = false;
    const float* base; float* C; int ldc, pad;
    __device__ __forceinline__ void operator()(const f32x4 (&acc)[2][2][4][2], const Unit& u, int wr, int wc, int fr, int fq) const {
        const int row0 = u.pm * BM + wr * 64 + fr, col0 = u.pn * BM + wc * 32 + 4 * fq;
#pragma unroll
        for (int ai = 0; ai < 2; ++ai) {
            f32x4 b[4][2][2];
#pragma unroll
            for (int m = 0; m < 4; ++m) { const size_t off = (size_t)(row0 + ai * HALF + m * 16) * ldc + col0;
#pragma unroll
                for (int bj = 0; bj < 2; ++bj)
#pragma unroll
                    for (int n = 0; n < 2; ++n) b[m][bj][n] = *(const f32x4*)(base + off + bj * HALF + n * 16); }
#pragma unroll
            for (int m = 0; m < 4; ++m) { const size_t off = (size_t)(row0 + ai * HALF + m * 16) * ldc + col0;
#pragma unroll
                for (int bj = 0; bj < 2; ++bj)
#pragma unroll
                    for (int n = 0; n < 2; ++n) *(f32x4*)(C + off + bj * HALF + n * 16) = acc[ai][bj][m][n] + b[m][bj][n]; }
        }
    }
};
struct EpiZ {
    static constexpr bool PERM = true, AFTER_DRAIN = false;
    bf16_t* O; float* gates; int ldc, pad;
    __device__ __forceinline__ void operator()(const f32x4 (&acc)[2][2][4][2], const Unit& u, int wr, int wc, int fr, int fq) const {
        const int row0 = u.pm * BM + wr * 64 + fr;
        if (u.pn < 9) {
            const int col0 = u.pn * BM + wc * 32 + 8 * fq;
#pragma unroll
            for (int ai = 0; ai < 2; ++ai)
#pragma unroll
                for (int m = 0; m < 4; ++m) { bf16_t* rowp = O + (size_t)(row0 + ai * HALF + m * 16) * ldc + col0;
#pragma unroll
                    for (int bj = 0; bj < 2; ++bj) { const f32x4 v0 = acc[ai][bj][m][0], v1 = acc[ai][bj][m][1];
                        u32x4 w; w.x = cvt_pk_bf16(v0[0], v0[1]); w.y = cvt_pk_bf16(v0[2], v0[3]); w.z = cvt_pk_bf16(v1[0], v1[1]); w.w = cvt_pk_bf16(v1[2], v1[3]);
                        *(u32x4*)(rowp + bj * HALF) = w; } }
        } else if (wc == 0 && fq < 3) {
#pragma unroll
            for (int ai = 0; ai < 2; ++ai)
#pragma unroll
                for (int m = 0; m < 4; ++m) { float* gp = gates + (size_t)(row0 + ai * HALF + m * 16) * 24 + 8 * fq;
#pragma unroll
                    for (int n = 0; n < 2; ++n) *(f32x4*)(gp + 4 * n) = acc[ai][0][m][n]; }
        }
    }
};
__device__ __forceinline__ const char* uni_ptr(const char* p) {
    const unsigned long long v = (unsigned long long)p; const unsigned lo = __builtin_amdgcn_readfirstlane((unsigned)v), hi = __builtin_amdgcn_readfirstlane((unsigned)(v >> 32));
    return (const char*)(((unsigned long long)hi << 32) | lo); }
#ifdef PROBE_GEPI
#define g_epi_time_ (*(unsigned long long*)epi_acc_ptr_)
#endif
template <class Epi, class Sched, bool ALIGN_EPI = false, bool SP2 = false>
__device__ __forceinline__ void gemm_phase(PG8_LAS unsigned char* lds, const Gemm g, const Sched& S, const Epi& E, unsigned long long* epi_acc_ptr_ = nullptr) {
    int tid_ = phase_tid();
    const int tid = tid_, wid = __builtin_amdgcn_readfirstlane(tid >> 6), lane = tid & 63, wr = wid >> 2, wc = wid & 3, fr = lane & 15, fq = lane >> 4;
    const int K = g.K, nt = K / BK;
    unsigned voffA[2], voffB[2];
#pragma unroll
    for (int i = 0; i < 2; ++i) { int R, C; stage_rc(tid * 16 + i * 8192, R, C); const int Rb = Epi::PERM ? ((R & ~31) + perm32(R & 31)) : R;
        voffA[i] = (unsigned)(R * K + C) * 2u; voffB[i] = (unsigned)(Rb * K + C) * 2u; }
    const size_t kstep = (size_t)(BK * 2);
    const size_t hstep = (size_t)HALF * K * 2;
    const size_t tstep = 2 * hstep;
    const unsigned ldsw = (unsigned)wid * 1024u;
    const int aoff = lds_byte(wr * 64 + fr, fq * 8), boff = lds_byte(wc * 32 + fr, fq * 8);
#define PG8_SA(b, h) (((b) * 2 + (h)) * HTB)
#define PG8_SB(b, h) ((4 + (b) * 2 + (h)) * HTB)
#define PG8_STAGE(bufoff, gbase, voff) do { _Pragma("unroll") for (int _i = 0; _i < 2; ++_i) \
        __builtin_amdgcn_global_load_lds((const unsigned*)((const char*)(gbase) + (voff)[_i]), (PG8_LAS unsigned*)(lds + (bufoff) + ldsw + _i * 8192), 16, 0, 0); } while (0)
#define PG8_LDA(dst, b, h) do { _Pragma("unroll") for (int m = 0; m < 4; ++m) _Pragma("unroll") for (int k = 0; k < 2; ++k) dst[m][k] = *(const PG8_LAS bf16x8*)(lds + PG8_SA(b, h) + aoff + m * 2048 + k * 1024); } while (0)
#define PG8_LDB(dst, b, h) do { _Pragma("unroll") for (int n = 0; n < 2; ++n) _Pragma("unroll") for (int k = 0; k < 2; ++k) dst[n][k] = *(const PG8_LAS bf16x8*)(lds + PG8_SB(b, h) + boff + n * 2048 + k * 1024); } while (0)
#define PG8_MMA(ai, bj, At, Bt) do { __builtin_amdgcn_s_setprio(1); _Pragma("unroll") for (int m = 0; m < 4; ++m) _Pragma("unroll") for (int n = 0; n < 2; ++n) _Pragma("unroll") for (int k = 0; k < 2; ++k) \
        acc[ai][bj][m][n] = __builtin_amdgcn_mfma_f32_16x16x32_bf16(Bt[n][k], At[m][k], acc[ai][bj][m][n], 0, 0, 0); __builtin_amdgcn_s_setprio(0); } while (0)
#define PG8_WAIT_V(n) asm volatile("s_waitcnt vmcnt(" #n ")" ::: "memory")
#define PG8_WAIT_L(n) asm volatile("s_waitcnt lgkmcnt(" #n ")" ::: "memory")
#define PG8_BAR __builtin_amdgcn_s_barrier()
#define PG8_SCHED __builtin_amdgcn_sched_barrier(0)
    Unit cur, nxt; int ui = 0;
    if (!S.next(0, cur)) return;
    f32x4 acc[2][2][4][2];
    bf16x8 At[4][2], B0[2][2], B1[2][2];
    const char* cA = uni_ptr((const char*)g.A + (size_t)cur.pm * tstep); const char* cB = uni_ptr((const char*)g.Bt + (size_t)cur.pn * tstep);
    S.a_ready(cur);
    if constexpr (SP2) {
        PG8_STAGE(PG8_SB(0, 0), cB, voffB); PG8_STAGE(PG8_SB(0, 1), cB + hstep, voffB); PG8_STAGE(PG8_SA(0, 0), cA, voffA); PG8_STAGE(PG8_SA(0, 1), cA + hstep, voffA);
        if (wr == 1) PG8_BAR;
        PG8_WAIT_V(2); PG8_BAR;
        PG8_STAGE(PG8_SB(1, 0), cB + kstep, voffB); PG8_STAGE(PG8_SA(1, 0), cA + kstep, voffA); PG8_STAGE(PG8_SB(1, 1), cB + hstep + kstep, voffB);
        PG8_WAIT_V(6); PG8_BAR;
    } else {
        PG8_STAGE(PG8_SB(0, 0), cB, voffB); PG8_STAGE(PG8_SA(0, 0), cA, voffA); PG8_STAGE(PG8_SB(0, 1), cB + hstep, voffB); PG8_STAGE(PG8_SA(0, 1), cA + hstep, voffA);
        if (wr == 1) PG8_BAR;
        PG8_WAIT_V(4); PG8_BAR;
        PG8_STAGE(PG8_SB(1, 0), cB + kstep, voffB); PG8_STAGE(PG8_SA(1, 0), cA + kstep, voffA); PG8_STAGE(PG8_SB(1, 1), cB + hstep + kstep, voffB);
        PG8_WAIT_V(6); PG8_BAR;
    }
    asm volatile("" ::: "memory");
#pragma unroll
    for (int a = 0; a < 2; ++a)
#pragma unroll
        for (int b = 0; b < 2; ++b)
#pragma unroll
            for (int m = 0; m < 4; ++m)
#pragma unroll
                for (int n = 0; n < 2; ++n) acc[a][b][m][n] = (f32x4){0.f, 0.f, 0.f, 0.f};
    for (;;) {
        const bool has_next = S.next(ui + 1, nxt);
        const char* nA = uni_ptr(has_next ? (const char*)g.A + (size_t)nxt.pm * tstep : cA); const char* nB = uni_ptr(has_next ? (const char*)g.Bt + (size_t)nxt.pn * tstep : cB);
        for (int t = 0; t < nt; t += 2) {
            const bool last = (t == nt - 2);
            const char* a1 = cA + (size_t)(t + 1) * kstep;
            const char* a2 = last ? nA : cA + (size_t)(t + 2) * kstep; const char* b2 = last ? nB : cB + (size_t)(t + 2) * kstep;
            const char* a3 = a2 + kstep; const char* b3 = b2 + kstep;
            if (last && has_next) S.a_ready(nxt);
            if constexpr (SP2) {
            PG8_LDB(B0, 0, 0); PG8_LDB(B1, 0, 1); PG8_SCHED; PG8_LDA(At, 0, 0); PG8_STAGE(PG8_SA(1, 1), a1 + hstep, voffA);
            PG8_WAIT_V(8); PG8_WAIT_L(0); PG8_BAR; PG8_MMA(0, 0, At, B0); PG8_MMA(0, 1, At, B1); PG8_BAR; PG8_SCHED;
            PG8_LDA(At, 0, 1); PG8_STAGE(PG8_SB(0, 0), b2, voffB); PG8_STAGE(PG8_SB(0, 1), b2 + hstep, voffB); PG8_STAGE(PG8_SA(0, 0), a2, voffA);
            PG8_WAIT_V(8); PG8_WAIT_L(0); PG8_BAR; PG8_MMA(1, 0, At, B0); PG8_MMA(1, 1, At, B1); PG8_BAR; PG8_SCHED;
            PG8_LDB(B0, 1, 0); PG8_LDB(B1, 1, 1); PG8_SCHED; PG8_LDA(At, 1, 0); PG8_STAGE(PG8_SA(0, 1), a2 + hstep, voffA);
            PG8_WAIT_V(8); PG8_WAIT_L(0); PG8_BAR; PG8_MMA(0, 0, At, B0); PG8_MMA(0, 1, At, B1); PG8_BAR; PG8_SCHED;
            PG8_LDA(At, 1, 1); PG8_STAGE(PG8_SB(1, 0), b3, voffB); PG8_STAGE(PG8_SB(1, 1), b3 + hstep, voffB); PG8_STAGE(PG8_SA(1, 0), a3, voffA);
            PG8_WAIT_V(8); PG8_WAIT_L(0); PG8_BAR; PG8_MMA(1, 0, At, B0); PG8_MMA(1, 1, At, B1); PG8_BAR; PG8_SCHED;
            } else {
            PG8_LDB(B0, 0, 0); PG8_SCHED; PG8_LDA(At, 0, 0); PG8_STAGE(PG8_SA(1, 1), a1 + hstep, voffA);
            PG8_WAIT_L(8); PG8_BAR; PG8_WAIT_L(0); PG8_MMA(0, 0, At, B0); PG8_BAR; PG8_SCHED;
            PG8_LDB(B1, 0, 1); PG8_STAGE(PG8_SB(0, 0), b2, voffB);
            PG8_BAR; PG8_WAIT_L(0); PG8_MMA(0, 1, At, B1); PG8_BAR;
            PG8_LDA(At, 0, 1); PG8_STAGE(PG8_SA(0, 0), a2, voffA);
            PG8_BAR; PG8_WAIT_L(0); PG8_MMA(1, 0, At, B0); PG8_BAR; PG8_SCHED;
            PG8_STAGE(PG8_SB(0, 1), b2 + hstep, voffB);
            PG8_WAIT_V(6); PG8_BAR; PG8_MMA(1, 1, At, B1); PG8_BAR;
            PG8_LDB(B0, 1, 0); PG8_SCHED; PG8_LDA(At, 1, 0); PG8_STAGE(PG8_SA(0, 1), a2 + hstep, voffA);
            PG8_WAIT_L(8); PG8_BAR; PG8_WAIT_L(0); PG8_MMA(0, 0, At, B0); PG8_BAR; PG8_SCHED;
            PG8_LDB(B1, 1, 1); PG8_STAGE(PG8_SB(1, 0), b3, voffB);
            PG8_BAR; PG8_WAIT_L(0); PG8_MMA(0, 1, At, B1); PG8_BAR;
            PG8_LDA(At, 1, 1); PG8_STAGE(PG8_SA(1, 0), a3, voffA);
            PG8_BAR; PG8_WAIT_L(0); PG8_MMA(1, 0, At, B0); PG8_BAR; PG8_SCHED;
            PG8_STAGE(PG8_SB(1, 1), b3 + hstep, voffB);
            PG8_WAIT_V(6); PG8_BAR; PG8_MMA(1, 1, At, B1); PG8_BAR;
            }
        }
        if constexpr (ALIGN_EPI) { if (wr == 0) PG8_BAR; }
#ifdef PROBE_GEPI
        { const unsigned long long te0_ = __builtin_amdgcn_s_memrealtime();
          if constexpr (!Epi::AFTER_DRAIN) { E(acc, cur, wr, wc, fr, fq); S.done(cur); }
          asm volatile("s_waitcnt vmcnt(0)" ::: "memory");
          if (tid == 0) g_epi_time_ += __builtin_amdgcn_s_memrealtime() - te0_; }
#else
        if constexpr (!Epi::AFTER_DRAIN) { E(acc, cur, wr, wc, fr, fq); S.done(cur); }
#endif
        if (!has_next) break;
#pragma unroll
        for (int a = 0; a < 2; ++a)
#pragma unroll
            for (int b = 0; b < 2; ++b)
#pragma unroll
                for (int m = 0; m < 4; ++m)
#pragma unroll
                    for (int n = 0; n < 2; ++n) acc[a][b][m][n] = (f32x4){0.f, 0.f, 0.f, 0.f};
        cur = nxt; cA = nA; cB = nB; ++ui;
        if constexpr (ALIGN_EPI) { if (wr == 1) PG8_BAR; }
    }
    PG8_WAIT_V(0);
    if constexpr (!ALIGN_EPI) { if (wr == 0) PG8_BAR; }
    PG8_BAR;
    if constexpr (Epi::AFTER_DRAIN) { E.fused(acc, cur, wr, wc, fr, fq, lds, wid, lane); S.done(cur); }
#undef PG8_SA
#undef PG8_SB
#undef PG8_STAGE
#undef PG8_LDA
#undef PG8_LDB
#undef PG8_MMA
#undef PG8_WAIT_V
#undef PG8_WAIT_L
#undef PG8_BAR
#undef PG8_SCHED
}
}

namespace att {
typedef short bf16x8 __attribute__((ext_vector_type(8)));
typedef short s16x4 __attribute__((ext_vector_type(4)));
typedef float f32x4 __attribute__((ext_vector_type(4)));
typedef unsigned u32x4 __attribute__((ext_vector_type(4)));
#define ATT_LAS __attribute__((address_space(3)))
constexpr int KBUF = 8192, SLOT = 16384;
constexpr int OFF_IMP = 4 * SLOT, IMP_LD = 264  , OFF_SEL = OFF_IMP + 64 * IMP_LD * 4, LDS_BYTES = OFF_SEL + 64 * 8 * 4;

__device__ __forceinline__ const unsigned char* uni_cptr(const unsigned char* p) {
    const unsigned long long v = (unsigned long long)p; const unsigned lo = __builtin_amdgcn_readfirstlane((unsigned)v), hi = __builtin_amdgcn_readfirstlane((unsigned)(v >> 32));
    return (const unsigned char*)(((unsigned long long)hi << 32) | lo); }
__device__ __forceinline__ void glds16(const void* sbase  , unsigned voff  , unsigned lds_dst) { unsigned keep;
    asm volatile("s_mov_b32 %0, m0\n\ts_mov_b32 m0, %3\n\ts_nop 0\n\tglobal_load_lds_dwordx4 %1, %2\n\ts_mov_b32 m0, %0" : "=&s"(keep) : "v"(voff), "s"(sbase), "s"(lds_dst) : "memory"); }
__device__ __forceinline__ void issue_kv(const unsigned char* kblk  , const unsigned char* vblk  , unsigned koff, unsigned voff, unsigned dst  ) {
    glds16(kblk, koff, dst); glds16(vblk, voff, dst + KBUF);
}
__device__ __forceinline__ float quad_sum(float v) {
    v += __builtin_bit_cast(float, __builtin_amdgcn_update_dpp(0, __builtin_bit_cast(int, v), 0xB1, 0xF, 0xF, true));
    v += __builtin_bit_cast(float, __builtin_amdgcn_update_dpp(0, __builtin_bit_cast(int, v), 0x4E, 0xF, 0xF, true));
    return v; }
#define ATT_WAIT_V(n) asm volatile("s_waitcnt vmcnt(" #n ")" ::: "memory")
typedef short v4i16_t __attribute__((ext_vector_type(4)));
__device__ __forceinline__ s16x4 vtr(const ATT_LAS unsigned char* p) { return __builtin_bit_cast(s16x4, __builtin_amdgcn_ds_read_tr16_b64_v4i16((ATT_LAS v4i16_t*)p)); }
typedef float f32x2_t __attribute__((ext_vector_type(2))); typedef __bf16 bf16x2_t __attribute__((ext_vector_type(2)));
__device__ __forceinline__ unsigned pk_bf16(float lo, float hi) { f32x2_t v = {lo, hi}; bf16x2_t b = __builtin_convertvector(v, bf16x2_t); return __builtin_bit_cast(unsigned, b); }

template <int MODE, bool MASKED>
__device__ __forceinline__ void block_compute(const ATT_LAS unsigned char* slot, const bf16x8 (&qf)[2][2], f32x4 (&O)[2][4], float (&l)[2], const int (&hi)[2], const int (&lo)[2],
                                              const float (&pscale)[2], const float (&bias)[2], ATT_LAS float* imp_row0, ATT_LAS float* imp_row1, int jb, int lane, bool act0 = true, bool act1 = true) {
    const int col16 = lane & 15, q4 = lane >> 4;
    const int ka0 = col16 * 128 + ((q4 ^ ((col16 >> 1) & 7)) << 4), ka1 = ka0 ^ 64;
    const int vq = col16 >> 2, vp_ = col16 & 3, vrow = 4 * q4 + vq, vrm = vrow & 7;
    const ATT_LAS unsigned char* vbase = slot + KBUF + vrow * 128 + 8 * (vp_ & 1);
    bf16x8 kf[2][2][2];
#pragma unroll
    for (int ks = 0; ks < 2; ++ks)
#pragma unroll
        for (int kt = 0; kt < 2; ++kt)
#pragma unroll
            for (int st = 0; st < 2; ++st) kf[ks][kt][st] = *(const ATT_LAS bf16x8*)(slot + 2048 * (2 * ks + kt) + (st == 0 ? ka0 : ka1));
    bf16x8 vf[2][4];
    if (MODE != 0) {
#pragma unroll
        for (int ks = 0; ks < 2; ++ks)
#pragma unroll
            for (int dt = 0; dt < 4; ++dt) { const ATT_LAS unsigned char* vp = vbase + 4096 * ks + (((2 * dt + (vp_ >> 1)) ^ vrm) << 4);
                const s16x4 a = vtr(vp), b = vtr(vp + 2048);
                vf[ks][dt] = (bf16x8){a[0], a[1], a[2], a[3], b[0], b[1], b[2], b[3]}; }
    }
#pragma unroll
    for (int cg = 0; cg < 2; ++cg) if (cg == 0 ? act0 : act1) {
        const float bz = MASKED ? 0.f : bias[cg];
        f32x4 s[2][2];
#pragma unroll
        for (int ks = 0; ks < 2; ++ks)
#pragma unroll
            for (int kt = 0; kt < 2; ++kt) { s[ks][kt] = (f32x4){bz, bz, bz, bz};
                s[ks][kt] = __builtin_amdgcn_mfma_f32_16x16x32_bf16(kf[ks][kt][0], qf[cg][0], s[ks][kt], 0, 0, 0);
                s[ks][kt] = __builtin_amdgcn_mfma_f32_16x16x32_bf16(kf[ks][kt][1], qf[cg][1], s[ks][kt], 0, 0, 0); }
#pragma unroll
        for (int ks = 0; ks < 2; ++ks) {
            const int kk0 = 32 * ks + 4 * q4;
            float p0[4], p1[4];
#pragma unroll
            for (int r = 0; r < 4; ++r) {
                const int ka = kk0 + r, kb = kk0 + 16 + r;
                if (MASKED) { p0[r] = (ka <= hi[cg] && ka > lo[cg]) ? __builtin_amdgcn_exp2f(s[ks][0][r]) : 0.f; p1[r] = (kb <= hi[cg] && kb > lo[cg]) ? __builtin_amdgcn_exp2f(s[ks][1][r]) : 0.f; }
                else { p0[r] = __builtin_amdgcn_exp2f(s[ks][0][r]); p1[r] = __builtin_amdgcn_exp2f(s[ks][1][r]); }
            }
            if (MODE == 1) {
#pragma unroll
                for (int r = 0; r < 4; ++r) { p0[r] *= pscale[cg]; p1[r] *= pscale[cg]; }
                float w0 = (p0[0] + p0[1]) + (p0[2] + p0[3]), c0 = p0[3], w1 = (p1[0] + p1[1]) + (p1[2] + p1[3]), c1 = p1[3];
                w0 = quad_sum(w0); c0 = quad_sum(c0); w1 = quad_sum(w1); c1 = quad_sum(c1);
                if ((col16 & 3) == 0) { ATT_LAS float* ir = (cg == 0 ? imp_row0 : imp_row1) + jb + 8 * ks + q4;
                    ir[0] += w0; ir[4] += w1; asm volatile("" ::: "memory"); ir[1] += c0; ir[5] += c1; asm volatile("" ::: "memory"); }
            } else {
                l[cg] += ((p0[0] + p0[1]) + (p0[2] + p0[3])) + ((p1[0] + p1[1]) + (p1[2] + p1[3]));
            }
            if (MODE != 0) {
                union { bf16x8 v; unsigned u[4]; } pf;
                pf.u[0] = pk_bf16(p0[0], p0[1]); pf.u[1] = pk_bf16(p0[2], p0[3]); pf.u[2] = pk_bf16(p1[0], p1[1]); pf.u[3] = pk_bf16(p1[2], p1[3]);
#pragma unroll
                for (int dt = 0; dt < 4; ++dt) O[cg][dt] = __builtin_amdgcn_mfma_f32_16x16x32_bf16(vf[ks][dt], pf.v, O[cg][dt], 0, 0, 0);
            }
        }
    }
}

struct Tensors { const bf16_t* Z; const bf16_t* KC; const bf16_t* VC; const float* gates; float* YATT; unsigned long long* tsec; };
#ifdef PROBE_TSEC
#define TSEC_MARK(k) do { if (tid == 0) { const unsigned long long now_ = __builtin_amdgcn_s_memrealtime(); T.tsec[k] += now_ - tlast_; tlast_ = now_; } } while (0)
#define TSEC_INIT() unsigned long long tlast_ = __builtin_amdgcn_s_memrealtime()
#else
#define TSEC_MARK(k) do { } while (0)
#define TSEC_INIT() do { } while (0)
#endif

__device__ __forceinline__ void attn_item(ATT_LAS unsigned char* lds, const Tensors& T, int b, int h, int tile) {
    int tid = phase_tid();
    const int lane = tid & 63, wv = tid >> 6, col16 = lane & 15, q4 = lane >> 4, g = col16 & 3;
    const int t0 = tile * 64, cur = tile, bh = b * 2 + h;
    ATT_LAS float* imp = (ATT_LAS float*)(lds + OFF_IMP); ATT_LAS unsigned* sel = (ATT_LAS unsigned*)(lds + OFF_SEL);
    int tq[2];
#pragma unroll
    for (int cg = 0; cg < 2; ++cg) tq[cg] = wv * 8 + cg * 4 + (col16 >> 2);
#define MROW(cg) ((size_t)b * SEQ + t0 + tq[cg])
    const int hq = h * 4 + g;
    bf16x8 qf[2][2];
#pragma unroll
    for (int cg = 0; cg < 2; ++cg)
#pragma unroll
        for (int st = 0; st < 2; ++st) qf[cg][st] = *(const bf16x8*)(T.Z + MROW(cg) * NZ + hq * 64 + st * 32 + q4 * 8);
    asm volatile("" : "+v"(qf[0][0]), "+v"(qf[0][1]), "+v"(qf[1][0]), "+v"(qf[1][1]));
    __syncthreads();
    TSEC_INIT();
    for (int e = tid; e < 64 * IMP_LD; e += 512) imp[e] = 0.f;
    for (int e = tid; e < 64 * 8; e += 512) sel[e] = 0u;
    f32x4 O[2][4];
    float l[2]; int hi[2], lo[2]; float psc[2] = {1.f, 1.f}, bias[2] = {0.f, 0.f};
#define imp0 (imp + tq[0] * IMP_LD)
#define imp1 (imp + tq[1] * IMP_LD)
    const unsigned lds0 = (unsigned)(uintptr_t)lds;
    const int wid = __builtin_amdgcn_readfirstlane(tid >> 6), r8 = tid >> 3, ck = ((tid & 7) ^ ((r8 >> 1) & 7)) * 8, cv = ((tid & 7) ^ (r8 & 7)) * 8;
#define RING_ISSUE(kb, vb, stride, blk, si) issue_kv(uni_cptr((const unsigned char*)((kb) + (size_t)(blk) * 64 * (stride))), uni_cptr((const unsigned char*)((vb) + (size_t)(blk) * 64 * (stride))), (unsigned)((r8 * (stride) + ck) * 2), (unsigned)((r8 * (stride) + cv) * 2), (unsigned)__builtin_amdgcn_readfirstlane((int)(lds0 + (si) * SLOT + wid * 1024)))
#define BLKMAP(x_) (x_)
#define GROUP_ISSUE(kb, vb, stride, first, nb, GS, gidx) { _Pragma("unroll") for (int d_ = 0; d_ < (GS); ++d_) RING_ISSUE(kb, vb, stride, BLKMAP((first) + min((gidx) * (GS) + d_, (nb) - 1)), ((gidx) & 1) * (GS) + d_); }
#define GROUP_ISSUE2(kb, vb, stride, first, nb, GS, bg, sg) { _Pragma("unroll") for (int d_ = 0; d_ < (GS); ++d_) RING_ISSUE(kb, vb, stride, BLKMAP((first) + min((bg) * (GS) + d_, (nb) - 1)), ((sg) & 1) * (GS) + d_); }
#define GROUP_BEGIN(kb, vb, stride, first, nb, GS, gidx) ATT_WAIT_V(0); __builtin_amdgcn_s_barrier(); GROUP_ISSUE(kb, vb, stride, first, nb, GS, (gidx) + 1)
#define GROUP_SLOT(GS, gidx, bi) (lds + ((((gidx) & 1) * (GS)) + (bi)) * SLOT)
#define RING_EPILOGUE() ATT_WAIT_V(0); __syncthreads();
    const int nk = min(NC, t0 / 16 + 3), nch = (nk + 63) >> 6, ngc = (nch + 1) >> 1;
    const int nmax0 = (t0 - 31) >> 4, cfull = nmax0 >= 0 ? min(nch, (nmax0 + 1) >> 6) : 0;
    const bf16_t* kcb = T.KC + (size_t)bh * 1024 * 64; const bf16_t* vcb = T.VC + (size_t)bh * 1024 * 64;
    int nmax[2];
#pragma unroll
    for (int cg = 0; cg < 2; ++cg) nmax[cg] = (t0 + tq[cg] - 31) >> 4;
    l[0] = 0.f; l[1] = 0.f; lo[0] = -1; lo[1] = -1;
    TSEC_MARK(0);
    const int crot = (int)((blockIdx.x >> 3) % (unsigned)nch);
#define CROT(c_) (((c_) + crot) % nch)
#undef BLKMAP
#define BLKMAP(x_) CROT(x_)
    {
        GROUP_ISSUE(kcb, vcb, 64, 0, nch, 2, 0);
        for (int gi = 0; gi < ngc; ++gi) {
            GROUP_BEGIN(kcb, vcb, 64, 0, nch, 2, gi);
            for (int bi = 0; bi < 2; ++bi) { const int cl = 2 * gi + bi; if (cl < nch) { const int c = CROT(cl); const ATT_LAS unsigned char* slot = GROUP_SLOT(2, gi, bi);
                if (c < cfull) block_compute<0, false>(slot, qf, O, l, hi, lo, psc, bias, imp0, imp1, 0, lane);
                else { hi[0] = nmax[0] - 64 * c; hi[1] = nmax[1] - 64 * c; block_compute<0, true>(slot, qf, O, l, hi, lo, psc, bias, imp0, imp1, 0, lane); } } }
        }
        RING_EPILOGUE();
    }
    TSEC_MARK(1);
#pragma unroll
    for (int cg = 0; cg < 2; ++cg) { float lt = l[cg]; lt += __shfl_xor(lt, 16); lt += __shfl_xor(lt, 32); psc[cg] = lt > 0.f ? 1.f / lt : 0.f; }
#pragma unroll
    for (int cg = 0; cg < 2; ++cg)
#pragma unroll
        for (int dt = 0; dt < 4; ++dt) O[cg][dt] = (f32x4){0.f, 0.f, 0.f, 0.f};
    {
        GROUP_ISSUE(kcb, vcb, 64, 0, nch, 2, 0);
        for (int gi = 0; gi < ngc; ++gi) {
            GROUP_BEGIN(kcb, vcb, 64, 0, nch, 2, gi);
            for (int bi = 0; bi < 2; ++bi) { const int cl = 2 * gi + bi; if (cl < nch) { const int c = CROT(cl); const ATT_LAS unsigned char* slot = GROUP_SLOT(2, gi, bi);
                if (c < cfull) block_compute<1, false>(slot, qf, O, l, hi, lo, psc, bias, imp0, imp1, 16 * c, lane);
                else { hi[0] = nmax[0] - 64 * c; hi[1] = nmax[1] - 64 * c; block_compute<1, true>(slot, qf, O, l, hi, lo, psc, bias, imp0, imp1, 16 * c, lane); } } }
        }
        RING_EPILOGUE();
    }
    TSEC_MARK(2);
#undef BLKMAP
#define BLKMAP(x_) (x_)
    const bf16_t* zb = T.Z + (size_t)b * SEQ * NZ + ZKV + h * 64;
    const bf16_t* kbw = zb + 4 * 128; const bf16_t* vbw = zb + 5 * 128; const int j0w = max(0, cur - 8), nbw = cur - j0w + 1, ngw = (nbw + 3) >> 2;
    const bf16_t* kbs = zb + 2 * 128; const bf16_t* vbs = zb + 3 * 128; const int nbs = cur + 1, ngs = (nbs + 3) >> 2;
    GROUP_ISSUE2(kbw, vbw, NZ, j0w, nbw, 4, 0, 0);
    {
        const int q = tid >> 3, sub = tid & 7;
        if (cur + 1 <= 16) { if (sub == 0) sel[q * 8] = (1u << (cur + 1)) - 1u; }
        else {
            if (sub == 0) { sel[q * 8] |= 1u; sel[q * 8 + (cur >> 5)] |= 1u << (cur & 31); sel[q * 8 + ((cur - 1) >> 5)] |= 1u << ((cur - 1) & 31); }
#pragma unroll 1
            for (int it = 0; it < 13; ++it) {
                asm volatile("" ::: "memory");
                float best = -1.f; int bj = 0x7fffffff;
#pragma unroll
                for (int kb = 0; kb < 2; ++kb) { float v[16];
#pragma unroll
                    for (int u = 0; u < 16; ++u) v[u] = imp[q * IMP_LD + 1 + sub + 8 * (kb * 16 + u)];
#pragma unroll
                    for (int u = 0; u < 16; ++u) { const int j = 1 + sub + 8 * (kb * 16 + u); if (j <= cur - 2 && v[u] > best) { best = v[u]; bj = j; } } }
                { float ob = __builtin_bit_cast(float, __builtin_amdgcn_update_dpp(0, __builtin_bit_cast(int, best), 0xB1, 0xF, 0xF, true)); int oj = __builtin_amdgcn_update_dpp(0, bj, 0xB1, 0xF, 0xF, true);
                  if (ob > best || (ob == best && oj < bj)) { best = ob; bj = oj; }
                  ob = __builtin_bit_cast(float, __builtin_amdgcn_update_dpp(0, __builtin_bit_cast(int, best), 0x4E, 0xF, 0xF, true)); oj = __builtin_amdgcn_update_dpp(0, bj, 0x4E, 0xF, 0xF, true);
                  if (ob > best || (ob == best && oj < bj)) { best = ob; bj = oj; }
                  ob = __shfl_xor(best, 4); oj = __shfl_xor(bj, 4);
                  if (ob > best || (ob == best && oj < bj)) { best = ob; bj = oj; } }
                if (sub == 0 && bj <= cur - 2) { imp[q * IMP_LD + bj] = -2.f; sel[q * 8 + (bj >> 5)] |= 1u << (bj & 31); }
            }
        }
    }
    TSEC_MARK(3);
#pragma unroll
    for (int cg = 0; cg < 2; ++cg) { const float gt = __builtin_amdgcn_rcpf(1.f + __expf(-T.gates[MROW(cg) * 24 + hq * 3 + 0]));
#pragma unroll
        for (int dt = 0; dt < 4; ++dt) *(f32x4*)(T.YATT + MROW(cg) * 512 + hq * 64 + 16 * dt + 4 * q4) = O[cg][dt] * gt; }
    __syncthreads();
    {
        l[0] = 0.f; l[1] = 0.f; bias[0] = 0.f; bias[1] = 0.f;
#pragma unroll
        for (int cg = 0; cg < 2; ++cg)
#pragma unroll
            for (int dt = 0; dt < 4; ++dt) O[cg][dt] = (f32x4){0.f, 0.f, 0.f, 0.f};
        for (int gi = 0; gi < ngw; ++gi) {
            ATT_WAIT_V(0); __builtin_amdgcn_s_barrier();
            if (gi + 1 < ngw) { GROUP_ISSUE2(kbw, vbw, NZ, j0w, nbw, 4, gi + 1, gi + 1) } else { GROUP_ISSUE2(kbs, vbs, NZ, 0, nbs, 4, 0, ngw) }
            for (int bi = 0; bi < 4; ++bi) { const int i = 4 * gi + bi; if (i < nbw) { const int j = j0w + i; const ATT_LAS unsigned char* slot = GROUP_SLOT(4, gi, bi);
                if (j == cur || j == cur - 8) {
#pragma unroll
                    for (int cg = 0; cg < 2; ++cg) { hi[cg] = (j == cur) ? tq[cg] : 63; lo[cg] = (j == cur - 8) ? tq[cg] : -1; }
                    block_compute<2, true>(slot, qf, O, l, hi, lo, psc, bias, imp0, imp1, 0, lane); }
                else block_compute<2, false>(slot, qf, O, l, hi, lo, psc, bias, imp0, imp1, 0, lane); } }
        }
#pragma unroll
        for (int cg = 0; cg < 2; ++cg) { float lt = l[cg]; lt += __shfl_xor(lt, 16); lt += __shfl_xor(lt, 32); const float sc = __builtin_amdgcn_rcpf(1.f + __expf(-T.gates[MROW(cg) * 24 + hq * 3 + 2])) / lt;
#pragma unroll
            for (int dt = 0; dt < 4; ++dt) { f32x4* yp = (f32x4*)(T.YATT + MROW(cg) * 512 + hq * 64 + 16 * dt + 4 * q4); *yp = *yp + O[cg][dt] * sc; } }
    }
    TSEC_MARK(4);
    {
        l[0] = 0.f; l[1] = 0.f; lo[0] = -1; lo[1] = -1;
#pragma unroll
        for (int cg = 0; cg < 2; ++cg)
#pragma unroll
            for (int dt = 0; dt < 4; ++dt) O[cg][dt] = (f32x4){0.f, 0.f, 0.f, 0.f};
        for (int gi = 0; gi < ngs; ++gi) {
            ATT_WAIT_V(0); __builtin_amdgcn_s_barrier();
            GROUP_ISSUE2(kbs, vbs, NZ, 0, nbs, 4, gi + 1, ngw + gi + 1);
            const unsigned sw0 = sel[tq[0] * 8 + (gi >> 3)] >> ((4 * gi) & 31), sw1 = sel[tq[1] * 8 + (gi >> 3)] >> ((4 * gi) & 31);
            for (int bi = 0; bi < 4; ++bi) { const int j = 4 * gi + bi; if (j < cur) {
                const bool s0 = (sw0 >> bi) & 1u, s1 = (sw1 >> bi) & 1u; const bool a0 = __any(s0), a1 = __any(s1);
                if (a0 || a1) { bias[0] = s0 ? 0.f : -1e30f; bias[1] = s1 ? 0.f : -1e30f; block_compute<2, false>(GROUP_SLOT(4, ngw + gi, bi), qf, O, l, hi, lo, psc, bias, imp0, imp1, 0, lane, a0, a1); } } }
            if ((cur >> 2) == gi) { hi[0] = tq[0]; hi[1] = tq[1]; block_compute<2, true>(GROUP_SLOT(4, ngw + gi, cur & 3), qf, O, l, hi, lo, psc, bias, imp0, imp1, 0, lane); }
        }
        RING_EPILOGUE();
#pragma unroll
        for (int cg = 0; cg < 2; ++cg) { float lt = l[cg]; lt += __shfl_xor(lt, 16); lt += __shfl_xor(lt, 32); const float sc = __builtin_amdgcn_rcpf(1.f + __expf(-T.gates[MROW(cg) * 24 + hq * 3 + 1])) / lt;
#pragma unroll
            for (int dt = 0; dt < 4; ++dt) { f32x4* yp = (f32x4*)(T.YATT + MROW(cg) * 512 + hq * 64 + 16 * dt + 4 * q4); *yp = *yp + O[cg][dt] * sc; } }
    }
    TSEC_MARK(5);
#undef RING_ISSUE
#undef GROUP_ISSUE
#undef BLKMAP
#undef CROT
#undef GROUP_BEGIN
#undef GROUP_ISSUE2
#undef GROUP_SLOT
#undef RING_EPILOGUE
#undef MROW
#undef imp0
#undef imp1
}
}

#define LAS __attribute__((address_space(3)))
#define XB_TMO      128
#define XB_XCNT(j)  (256  + 64 * (j))
#define XB_XSUB(j)  (1280 + 64 * (j))
#define XB_XGEN(j)  (2304 + 64 * (j))
#define XB_TOP      3328
#define XB_TOPGEN   3392
#define XCD_BAR_WORDS 3456
#define XB_SPIN_CAP (1u << 18)

__device__ __forceinline__ unsigned xb_ld(unsigned* p)              { return __hip_atomic_load(p, __ATOMIC_RELAXED, __HIP_MEMORY_SCOPE_AGENT); }
__device__ __forceinline__ unsigned xb_add(unsigned* p, unsigned v) { return __hip_atomic_fetch_add(p, v, __ATOMIC_RELAXED, __HIP_MEMORY_SCOPE_AGENT); }
__device__ __forceinline__ unsigned xb_xcc_id() { return (unsigned)__builtin_amdgcn_s_getreg((3 << 11) | 20) & 0xFu; }
#define XB_SPIN(cond, bar) do { unsigned _sp = 0; while (cond) { __builtin_amdgcn_s_sleep(1); \
    if ((++_sp & 255u) == 0u) { if (xb_ld(&(bar)[XB_TMO])) break; if (_sp > XB_SPIN_CAP) { atomicAdd(&(bar)[XB_TMO], 1u); break; } } } } while (0)

struct XcdBarrier {
    unsigned* bar; unsigned x;
    volatile LAS unsigned* st;
};

__device__ __forceinline__ XcdBarrier xcd_barrier_post(unsigned* bar, volatile LAS unsigned* st) {
    XcdBarrier b; b.bar = bar; b.x = xb_xcc_id(); b.st = st;
    if (phase_tid() == 0) (void)xb_add(&bar[XB_XCNT(b.x)], 1u);
    return b;
}
__device__ __forceinline__ void xcd_barrier_complete(unsigned* bar, unsigned x, unsigned& nloc, unsigned& nx) {
    const unsigned G = gridDim.x * gridDim.y * gridDim.z;
    unsigned sum, cnt, mine, sp = 0u;
    for (;;) {
        sum = 0u; cnt = 0u; mine = 0u;
#pragma unroll
        for (unsigned j = 0; j < 16; ++j) { const unsigned c = xb_ld(&bar[XB_XCNT(j)]); sum += c; cnt += (c > 0u) ? 1u : 0u; mine = (j == x) ? c : mine; }
        if (sum == G) break;
        __builtin_amdgcn_s_sleep(1);
        if ((++sp & 255u) == 0u) { if (xb_ld(&bar[XB_TMO])) break; if (sp > XB_SPIN_CAP) { atomicAdd(&bar[XB_TMO], 1u); break; } }
    }
    nloc = mine > 0u ? mine : 1u; nx = cnt > 0u ? cnt : 1u;
}

__device__ __forceinline__ void xcd_barrier(const XcdBarrier& b) {
    asm volatile("s_waitcnt vmcnt(0)" ::: "memory");
    __syncthreads();
    if (phase_tid() == 0) {
        unsigned* bar = b.bar;
        __builtin_amdgcn_s_waitcnt(0);
        unsigned nloc = b.st[0], nx = b.st[1];
        if (nloc == 0u) { xcd_barrier_complete(bar, b.x, nloc, nx); b.st[0] = nloc; b.st[1] = nx; }
        const unsigned old = xb_add(&bar[XB_XSUB(b.x)], 1u);
        const unsigned gen = old / nloc;
        if (old + 1u == (gen + 1u) * nloc) {
            __builtin_amdgcn_fence(__ATOMIC_RELEASE, "agent");
            asm volatile("s_waitcnt vmcnt(0)" ::: "memory");
            const unsigned og = xb_add(&bar[XB_TOP], 1u);
            const unsigned tg = og / nx;
            if (og + 1u == (tg + 1u) * nx) xb_add(&bar[XB_TOPGEN], 1u);
            else XB_SPIN(xb_ld(&bar[XB_TOPGEN]) == tg, bar);
            __builtin_amdgcn_fence(__ATOMIC_ACQUIRE, "agent");
            xb_add(&bar[XB_XGEN(b.x)], 1u);
            asm volatile("s_waitcnt vmcnt(0)" ::: "memory");
        } else {
            XB_SPIN(xb_ld(&bar[XB_XGEN(b.x)]) == gen, bar);
            __builtin_amdgcn_fence(__ATOMIC_ACQUIRE, "agent");
            asm volatile("s_waitcnt vmcnt(0)" ::: "memory");
        }
    }
    __syncthreads();
}


#define LAS3 __attribute__((address_space(3)))

struct TrJob { const float* W; bf16_t* WT; int K, ldw, col_off, row_off, ntx, nty; };
__device__ __forceinline__ void ph_transpose(const TrJob& J, LAS3 unsigned char* lds) {
    int tid_ = phase_tid(); const int tid = tid_, sub = tid >> 8, tid256 = tid & 255, tx = tid256 & 31, ty = tid256 >> 5;
    constexpr int NS = 4;
    const int nsx = (J.ntx + NS - 1) / NS, nstrip = nsx * J.nty;
    LAS3 float* t = (LAS3 float*)lds + sub * (NS * 32 * 33);
    for (int base = blockIdx.x * 2; base < nstrip; base += gridDim.x * 2) {
        const int strip = base + sub; const bool valid = strip < nstrip; const int sx = valid ? strip % nsx : 0, by = valid ? strip / nsx : 0, k0 = by * 32;
        float v[NS][4];
#pragma unroll
        for (int s = 0; s < NS; ++s) { const int bx = sx * NS + s; const bool ok = valid && bx < J.ntx; const int n0 = (ok ? bx : 0) * 32;
#pragma unroll
            for (int i = 0; i < 4; ++i) v[s][i] = ok ? J.W[(size_t)(k0 + ty + 8 * i) * J.ldw + J.col_off + n0 + tx] : 0.f; }
        __syncthreads();
#pragma unroll
        for (int s = 0; s < NS; ++s)
#pragma unroll
            for (int i = 0; i < 4; ++i) t[s * (32 * 33) + (ty + 8 * i) * 33 + tx] = v[s][i];
        __syncthreads();
#pragma unroll
        for (int s = 0; s < NS; ++s) { const int bx = sx * NS + s; const bool ok = valid && bx < J.ntx; const int n0 = bx * 32;
            if (ok) {
#pragma unroll
                for (int i = 0; i < 4; ++i) J.WT[(size_t)(J.row_off + n0 + ty + 8 * i) * J.K + k0 + tx] = (bf16_t)f2bf(t[s * (32 * 33) + tx * 33 + ty + 8 * i]); } }
    }
}
__device__ __forceinline__ void ph_rmsnorm(const float* __restrict__ x, const float* __restrict__ gamma, bf16_t* __restrict__ xn, float* __restrict__ rstd) {
    int tid_ = phase_tid(); const int lane = tid_ & 63, wv = tid_ >> 6;
    float4 g[4];
#pragma unroll
    for (int j = 0; j < 4; ++j) g[j] = ((const float4*)gamma)[lane + 64 * j];
    for (int row0 = (blockIdx.x * 8 + wv) * 4; row0 < MTOK; row0 += gridDim.x * 32) {
        float4 v[4][4];
#pragma unroll
        for (int r = 0; r < 4; ++r)
#pragma unroll
            for (int j = 0; j < 4; ++j) v[r][j] = ((const float4*)(x + (size_t)(row0 + r) * D_MODEL))[lane + 64 * j];
#pragma unroll
        for (int r = 0; r < 4; ++r) { float s = 0.f;
#pragma unroll
            for (int j = 0; j < 4; ++j) s += (v[r][j].x * v[r][j].x + v[r][j].y * v[r][j].y) + (v[r][j].z * v[r][j].z + v[r][j].w * v[r][j].w);
            const float rr = rsqrtf(wave_sum(s) * (1.f / D_MODEL) + 1e-6f);
            if (lane == 0) rstd[row0 + r] = rr;
            uint2* o = (uint2*)(xn + (size_t)(row0 + r) * D_MODEL) + lane;
#pragma unroll
            for (int j = 0; j < 4; ++j) { uint2 w; w.x = f2bf(v[r][j].x * rr * g[j].x) | (f2bf(v[r][j].y * rr * g[j].y) << 16); w.y = f2bf(v[r][j].z * rr * g[j].z) | (f2bf(v[r][j].w * rr * g[j].w) << 16); o[64 * j] = w; } }
    }
}
__device__ __forceinline__ void ph_gates(const float* __restrict__ x, const float* __restrict__ gamma, const float* __restrict__ w_in, float* __restrict__ gates) {
    int tid_ = phase_tid(); const int tid = tid_; if (tid >= 384) return;
    const int j = tid % 24, slot = tid / 24;
    for (int m0 = blockIdx.x * 64 + slot * 4; m0 < MTOK; m0 += gridDim.x * 64) {
        float a0 = 0.f, a1 = 0.f, a2 = 0.f, a3 = 0.f, q0 = 0.f, q1 = 0.f, q2 = 0.f, q3 = 0.f;
        const float* x0 = x + (size_t)m0 * D_MODEL;
        for (int k = 0; k < D_MODEL; ++k) { const float w = w_in[(size_t)k * N_IN + OFF_GATE_SRC + j] * gamma[k];
            const float v0 = x0[k], v1 = x0[D_MODEL + k], v2 = x0[2 * D_MODEL + k], v3 = x0[3 * D_MODEL + k];
            a0 += v0 * w; a1 += v1 * w; a2 += v2 * w; a3 += v3 * w; q0 += v0 * v0; q1 += v1 * v1; q2 += v2 * v2; q3 += v3 * v3; }
        gates[(size_t)(m0 + 0) * 24 + j] = sigmoidf_(a0 * rsqrtf(q0 * (1.f / D_MODEL) + 1e-6f)); gates[(size_t)(m0 + 1) * 24 + j] = sigmoidf_(a1 * rsqrtf(q1 * (1.f / D_MODEL) + 1e-6f));
        gates[(size_t)(m0 + 2) * 24 + j] = sigmoidf_(a2 * rsqrtf(q2 * (1.f / D_MODEL) + 1e-6f)); gates[(size_t)(m0 + 3) * 24 + j] = sigmoidf_(a3 * rsqrtf(q3 * (1.f / D_MODEL) + 1e-6f));
    }
}
__device__ __forceinline__ void ph_qknorm(bf16_t* __restrict__ Z, const float* __restrict__ qn, const float* __restrict__ kn) {
    int tid_ = phase_tid(); const int lane = tid_ & 63, wv = tid_ >> 6, sub = lane >> 4, e = (lane & 15) * 4;
    for (int m0 = (blockIdx.x * 8 + wv) * 4; m0 < MTOK; m0 += gridDim.x * 32) {
        uint2 w[4][3];
#pragma unroll
        for (int r = 0; r < 4; ++r)
#pragma unroll
            for (int p = 0; p < 3; ++p) { const int v = p * 4 + sub; const int col = v < 8 ? v * 64 : (v < 10 ? ZKV + 2 * 128 + (v - 8) * 64 : ZKV + 4 * 128 + (v - 10) * 64);
                w[r][p] = *(const uint2*)(Z + (size_t)(m0 + r) * NZ + col + e); }
#pragma unroll
        for (int r = 0; r < 4; ++r)
#pragma unroll
            for (int p = 0; p < 3; ++p) {
                const int v = p * 4 + sub;
                const int col = v < 8 ? v * 64 : (v < 10 ? ZKV + 2 * 128 + (v - 8) * 64 : ZKV + 4 * 128 + (v - 10) * 64);
                const float* gm = v < 8 ? qn : (v < 10 ? kn + 64 : kn + 128);
                const float sc = v < 8 ? 0.125f * 1.4426950408889634f : 1.f;
                const float a = bf2f(w[r][p].x & 0xffff), b = bf2f(w[r][p].x >> 16), c = bf2f(w[r][p].y & 0xffff), d = bf2f(w[r][p].y >> 16);
                const float s = row16_sum(a * a + b * b + c * c + d * d);
                const float rr = rsqrtf(s * (1.f / 64.f) + 1e-6f) * sc;
                uint2 o; o.x = f2bf(a * rr * gm[e]) | (f2bf(b * rr * gm[e + 1]) << 16); o.y = f2bf(c * rr * gm[e + 2]) | (f2bf(d * rr * gm[e + 3]) << 16);
                *(uint2*)(Z + (size_t)(m0 + r) * NZ + col + e) = o; }
    }
}
__device__ __forceinline__ void ph_xcast(const float* __restrict__ x, bf16_t* __restrict__ xb, float* __restrict__ ssqp) {
    int tid_ = phase_tid(); const int lane = tid_ & 63, wv = tid_ >> 6;
    for (int row = blockIdx.x * 8 + wv; row < MTOK; row += gridDim.x * 8) {
        const float4* xr = (const float4*)(x + (size_t)row * D_MODEL) + lane;
        float4 v[4]; float s = 0.f;
#pragma unroll
        for (int j = 0; j < 4; ++j) { v[j] = xr[64 * j]; s += (v[j].x * v[j].x + v[j].y * v[j].y) + (v[j].z * v[j].z + v[j].w * v[j].w); }
        s = wave_sum(s);
        if (lane < 16) ssqp[(size_t)row * 16 + lane] = lane == 0 ? s : 0.f;
        uint2* o = (uint2*)(xb + (size_t)row * D_MODEL) + lane;
#pragma unroll
        for (int j = 0; j < 4; ++j) { uint2 w; w.x = f2bf(v[j].x) | (f2bf(v[j].y) << 16); w.y = f2bf(v[j].z) | (f2bf(v[j].w) << 16); o[64 * j] = w; }
    }
}

struct CmpArgs { const bf16_t* Z; const float* pos; const float* w1; const float* w2; const float* kn0; bf16_t* KC; bf16_t* VC; };
__device__ __forceinline__ void ph_compress(const CmpArgs& A, LAS3 unsigned char* lds) {
    int tid_ = phase_tid(); const int sub = tid_ >> 7, tid = tid_ & 127;
    LAS3 unsigned short* zs = (LAS3 unsigned short*)(lds + sub * 22528); LAS3 float* hid = (LAS3 float*)(lds + sub * 22528 + 18432);
    for (int it0 = blockIdx.x * 4; it0 < 1024; it0 += gridDim.x * 4) {
        const int item = it0 + sub, kv = item >> 9, bx = item & 511, bh = bx >> 7, ig = bx & 127, b = bh >> 1, h = bh & 1, i0 = ig * 8;
        const int col = ZKV + kv * 128 + h * 64;
        __syncthreads();
        for (int e = tid; e < 144 * 8; e += 128) { const int tt = e >> 3, c8 = (e & 7) * 8; const int tok = 16 * i0 + tt;
            uint4 w = make_uint4(0u, 0u, 0u, 0u); if (tok < SEQ) w = *(const uint4*)(A.Z + (size_t)(b * SEQ + tok) * NZ + col + c8);
            LAS3 unsigned* d = (LAS3 unsigned*)(zs + tt * 64 + c8); d[0] = w.x; d[1] = w.y; d[2] = w.z; d[3] = w.w; }
        __syncthreads();
        const float* W1 = A.w1 + (size_t)kv * 2048 * 128; const float* P = A.pos + kv * 2048;
        float acc[8]; float cb = 0.f;
#pragma unroll
        for (int r = 0; r < 8; ++r) acc[r] = 0.f;
        for (int l = 0; l < 32; ++l)
            for (int d = 0; d < 64; ++d) { const float w = W1[(size_t)(l * 64 + d) * 128 + tid]; cb += P[l * 64 + d] * w;
#pragma unroll
                for (int r = 0; r < 8; ++r) acc[r] += bf2f(zs[(16 * r + l) * 64 + d]) * w; }
#pragma unroll
        for (int r = 0; r < 8; ++r) hid[r * 128 + tid] = gelu_tanh(acc[r] + cb);
        __syncthreads();
        const int c = tid & 63, half = tid >> 6; const float* W2 = A.w2 + kv * 128 * 64;
        float o[4] = {0.f, 0.f, 0.f, 0.f};
        for (int j = 0; j < 128; ++j) { const float w = W2[j * 64 + c];
#pragma unroll
            for (int r = 0; r < 4; ++r) o[r] += hid[(half * 4 + r) * 128 + j] * w; }
#pragma unroll
        for (int r = 0; r < 4; ++r) { const int i = i0 + half * 4 + r; float val = o[r];
            const float ss = wave_sum(val * val); if (kv == 0) val = val * rsqrtf(ss * (1.f / 64.f) + 1e-6f) * A.kn0[c];
            bf16_t* dst = (kv == 0 ? A.KC : A.VC) + ((size_t)bh * 1024 + i) * 64 + c; *dst = (bf16_t)f2bf(i < NC ? val : 0.f); }
    }
}


struct Cmp2Args { const bf16_t* Z; const bf16_t* W1cT  ; const bf16_t* W2P  ; const float* cb  ; const float* kn0; bf16_t* KC; bf16_t* VC; };
__device__ __forceinline__ void ph_compress_mfma(const Cmp2Args& A, LAS3 unsigned char* lds) {
    typedef short bf16x8 __attribute__((ext_vector_type(8))); typedef float f32x4 __attribute__((ext_vector_type(4)));
    int tid_ = phase_tid(); const int lane = tid_ & 63, wv = tid_ >> 6, col16 = lane & 15, q4 = lane >> 4;
    const int grp = wv >> 2, kq = wv & 3;
    LAS3 f32x4* red = (LAS3 f32x4*)lds + (size_t)grp * (3 * 8 * 64);
    for (int it0 = (int)blockIdx.x * 2; it0 < 512; it0 += 2 * (int)gridDim.x) {
        const int item = it0 + grp;
        const int kv = item >> 8, bh = (item >> 6) & 3, mt = item & 63, b = bh >> 1, h = bh & 1, irow = mt * 16 + col16;
        const int tokb = irow < NC ? 16 * irow : 0;
        const bf16_t* zp = A.Z + ((size_t)b * SEQ + tokb) * NZ + ZKV + kv * 128 + h * 64 + 8 * q4;
        const bf16_t* wp = A.W1cT + (size_t)kv * 128 * 2048 + (size_t)col16 * 2048 + 8 * q4;
        f32x4 acc[8];
#pragma unroll
        for (int nt = 0; nt < 8; ++nt) acc[nt] = (f32x4){0.f, 0.f, 0.f, 0.f};
        const int rot = (item * 5) & 15;
#pragma unroll 4
        for (int s_ = 0; s_ < 16; ++s_) { const int step = 16 * kq + ((s_ + rot) & 15);
            const bf16x8 zf = *(const bf16x8*)(zp + (size_t)(step >> 1) * NZ + (step & 1) * 32);
#pragma unroll
            for (int nt = 0; nt < 8; ++nt) { const bf16x8 wf = *(const bf16x8*)(wp + (size_t)nt * 16 * 2048 + step * 32); acc[nt] = __builtin_amdgcn_mfma_f32_16x16x32_bf16(wf, zf, acc[nt], 0, 0, 0); }
        }
        __syncthreads();
        if (kq != 0) {
#pragma unroll
            for (int nt = 0; nt < 8; ++nt) red[((kq - 1) * 8 + nt) * 64 + lane] = acc[nt]; }
        __syncthreads();
        if (kq == 0) {
#pragma unroll
            for (int nt = 0; nt < 8; ++nt) acc[nt] = acc[nt] + red[(0 * 8 + nt) * 64 + lane] + red[(1 * 8 + nt) * 64 + lane] + red[(2 * 8 + nt) * 64 + lane];
            bf16x8 hb[4];
#pragma unroll
            for (int s = 0; s < 4; ++s) { const f32x4 c0 = *(const f32x4*)(A.cb + kv * 128 + 32 * s + 4 * q4), c1 = *(const f32x4*)(A.cb + kv * 128 + 32 * s + 16 + 4 * q4);
                union { bf16x8 v; unsigned u[4]; } pk; const f32x4 a0 = acc[2 * s] + c0, a1 = acc[2 * s + 1] + c1;
                pk.u[0] = f2bf(gelu_tanh(a0[0])) | (f2bf(gelu_tanh(a0[1])) << 16); pk.u[1] = f2bf(gelu_tanh(a0[2])) | (f2bf(gelu_tanh(a0[3])) << 16);
                pk.u[2] = f2bf(gelu_tanh(a1[0])) | (f2bf(gelu_tanh(a1[1])) << 16); pk.u[3] = f2bf(gelu_tanh(a1[2])) | (f2bf(gelu_tanh(a1[3])) << 16);
                hb[s] = pk.v; }
            f32x4 o[4];
#pragma unroll
            for (int ct = 0; ct < 4; ++ct) { o[ct] = (f32x4){0.f, 0.f, 0.f, 0.f};
#pragma unroll
                for (int s = 0; s < 4; ++s) { const bf16x8 w2f = *(const bf16x8*)(A.W2P + ((size_t)((((kv * 4 + ct) * 4 + s) * 4 + q4) * 16 + col16)) * 8); o[ct] = __builtin_amdgcn_mfma_f32_16x16x32_bf16(w2f, hb[s], o[ct], 0, 0, 0); } }
            if (kv == 0) {
                float ss = 0.f;
#pragma unroll
                for (int ct = 0; ct < 4; ++ct) ss += (o[ct][0] * o[ct][0] + o[ct][1] * o[ct][1]) + (o[ct][2] * o[ct][2] + o[ct][3] * o[ct][3]);
                ss += __shfl_xor(ss, 16); ss += __shfl_xor(ss, 32);
                const float r = rsqrtf(ss * (1.f / 64.f) + 1e-6f);
#pragma unroll
                for (int ct = 0; ct < 4; ++ct) { const f32x4 g = *(const f32x4*)(A.kn0 + 16 * ct + 4 * q4); o[ct] = o[ct] * r * g; }
            }
            bf16_t* dst = (kv == 0 ? A.KC : A.VC) + ((size_t)bh * 1024 + irow) * 64 + 4 * q4;
#pragma unroll
            for (int ct = 0; ct < 4; ++ct) { uint2 w; w.x = f2bf(o[ct][0]) | (f2bf(o[ct][1]) << 16); w.y = f2bf(o[ct][2]) | (f2bf(o[ct][3]) << 16); if (irow >= NC) { w.x = 0u; w.y = 0u; } *(uint2*)(dst + 16 * ct) = w; }
        }
    }
}
__device__ __forceinline__ void ph_cmp_prep(const float* __restrict__ pos  , const float* __restrict__ w1  , const float* __restrict__ w2  , float* __restrict__ cb  , bf16_t* __restrict__ W2P  ) {
    int tid_ = phase_tid(); const int lane = tid_ & 63, wv = tid_ >> 6;
    for (int o = (int)blockIdx.x * 8 + wv; o < 512; o += 8 * (int)gridDim.x) { const int m = o >> 7, n = o & 127; float s = 0.f;
        for (int k = lane; k < 2048; k += 64) s += pos[m * 2048 + k] * w1[((size_t)m * 2048 + k) * 128 + n];
        s = wave_sum(s); if (lane == 0) cb[o] = s; }
    for (int e = (int)blockIdx.x * 512 + tid_; e < 4 * 8192; e += 512 * (int)gridDim.x) { const int m = e >> 13, r = e & 8191, j = r & 7, c16 = (r >> 3) & 15, q4 = (r >> 7) & 3, s = (r >> 9) & 3, ct = r >> 11;
        const int n = 32 * s + (j < 4 ? 4 * q4 + j : 16 + 4 * q4 + (j - 4)), c = 16 * ct + c16;
        W2P[e] = (bf16_t)f2bf(w2[((size_t)m * 128 + n) * 64 + c]); }
}

struct LruArgs { const bf16_t* Z; const float* cw; const float* cbias; const float* wa; const float* ba; const float* wx; const float* bx; const float* lam; float* Hloc; float* Pc; float* SP; float* SH; float* CIN; };
__device__ __forceinline__ void ph_lru1(const LruArgs& A, LAS3 unsigned char* lds) {
    int tid_ = phase_tid(); const int sub = tid_ >> 8, c = tid_ & 255;
    LAS3 float* xs = (LAS3 float*)(lds + sub * 32768);
    for (int it0 = blockIdx.x * 2; it0 < 1024; it0 += gridDim.x * 2) {
        const int item = it0 + sub, chunk = item & 511, b = item >> 9, t0 = chunk * 32;
        const float w0 = A.cw[c], w1 = A.cw[256 + c], w2 = A.cw[512 + c], w3 = A.cw[768 + c], bb = A.cbias[c];
        const bf16_t* zx = A.Z + (size_t)(b * SEQ) * NZ + ZLX + c;
        float xm3 = t0 >= 3 ? bf2f(zx[(size_t)(t0 - 3) * NZ]) : 0.f, xm2 = t0 >= 2 ? bf2f(zx[(size_t)(t0 - 2) * NZ]) : 0.f, xm1 = t0 >= 1 ? bf2f(zx[(size_t)(t0 - 1) * NZ]) : 0.f;
        __syncthreads();
        { unsigned short rx[32];
#pragma unroll
          for (int tt = 0; tt < 32; ++tt) rx[tt] = zx[(size_t)(t0 + tt) * NZ];
#pragma unroll
          for (int tt = 0; tt < 32; ++tt) { const float x0 = bf2f(rx[tt]); xs[tt * 256 + c] = bb + w0 * xm3 + w1 * xm2 + w2 * xm1 + w3 * x0; xm3 = xm2; xm2 = xm1; xm1 = x0; } }
        __syncthreads();
        const int hh = c >> 5, j = c & 31;
        float war[32], wxr[32];
#pragma unroll
        for (int i = 0; i < 32; ++i) { war[i] = A.wa[(hh * 32 + i) * 32 + j]; wxr[i] = A.wx[(hh * 32 + i) * 32 + j]; }
        const float bac = A.ba[c], bxc = A.bx[c]; const float sp = log1pf(expf(-A.lam[c]));
        float hst = 0.f, pr = 1.f;
#pragma unroll 8
        for (int tt = 0; tt < 32; ++tt) {
            float ra = 0.f, rx = 0.f;
#pragma unroll
            for (int i = 0; i < 32; ++i) { const float xv = xs[tt * 256 + hh * 32 + i]; ra += xv * war[i]; rx += xv * wxr[i]; }
            const float r = __builtin_amdgcn_rcpf(1.f + __expf(-(ra + bac))), ig = __builtin_amdgcn_rcpf(1.f + __expf(-(rx + bxc)));
            const float log_a = -8.f * r * sp, x2 = 2.f * log_a;
            const float em1 = log_a * (1.f + log_a * (0.5f + log_a * (0.16666667f + log_a * (0.041666668f + log_a * (0.0083333338f + log_a * 0.0013888889f)))));
            const float em2 = x2 * (1.f + x2 * (0.5f + x2 * (0.16666667f + x2 * (0.041666668f + x2 * (0.0083333338f + x2 * (0.0013888889f + x2 * 0.00019841270f))))));
            const float a = (log_a > -0.25f) ? 1.f + em1 : __expf(log_a), mult = sqrtf((log_a > -0.125f) ? -em2 : 1.f - a * a);
            const float u = xs[tt * 256 + c] * ig * mult;
            hst = a * hst + u; pr *= a;
            const size_t o = (size_t)(b * SEQ + t0 + tt) * 256 + c; A.Hloc[o] = hst; A.Pc[o] = pr; }
        A.SP[(size_t)(b * 512 + chunk) * 256 + c] = pr; A.SH[(size_t)(b * 512 + chunk) * 256 + c] = hst;
    }
}
__device__ __forceinline__ void ph_lru2(const LruArgs& A, LAS3 unsigned char* lds, int k) {
    int tid_ = phase_tid(); const int lp = tid_ & 31, g = tid_ >> 5, p = 32 * k + lp, b = p >> 8, c = p & 255;
    LAS3 float* aggP = (LAS3 float*)lds; LAS3 float* aggH = aggP + 512;
    const float* __restrict__ sp = A.SP + (size_t)(b * 512 + 32 * g) * 256 + c; const float* __restrict__ sh = A.SH + (size_t)(b * 512 + 32 * g) * 256 + c;
    float* __restrict__ cin = A.CIN + (size_t)(b * 512 + 32 * g) * 256 + c;
    float vp[32], vh[32];
#pragma unroll
    for (int i = 0; i < 32; ++i) { vp[i] = sp[(size_t)i * 256]; vh[i] = sh[(size_t)i * 256]; }
    float P = 1.f, Hh = 0.f;
#pragma unroll
    for (int i = 0; i < 32; ++i) { Hh = vp[i] * Hh + vh[i]; P *= vp[i]; }
    __syncthreads();
    aggP[g * 32 + lp] = P; aggH[g * 32 + lp] = Hh;
    __syncthreads();
    float run = 0.f;
    for (int gg = 0; gg < g; ++gg) run = aggP[gg * 32 + lp] * run + aggH[gg * 32 + lp];
#pragma unroll
    for (int i = 0; i < 32; ++i) { cin[(size_t)i * 256] = run; run = vp[i] * run + vh[i]; }
}

struct ConvArgs { const bf16_t* Z; const float* dw; const float* dwb; const float* lng; const float* lnb; float* YCV; };
__device__ __forceinline__ void ph_conv(const ConvArgs& A, LAS3 unsigned char* lds) {
    int tid_ = phase_tid(); const int sub = tid_ >> 8, c = tid_ & 255, wv = c >> 6;
    LAS3 float* gl = (LAS3 float*)(lds + sub * 47360); LAS3 float* red = (LAS3 float*)(lds + sub * 47360 + 47104);
    for (int it0 = blockIdx.x * 2; it0 < 2048; it0 += gridDim.x * 2) {
        const int item = it0 + sub, chunk = item & 1023, b = item >> 10, t0 = chunk * 16;
        __syncthreads();
#pragma unroll
        for (int hb = 0; hb < 2; ++hb) { unsigned short ra[23], rg[23];
#pragma unroll
            for (int u = 0; u < 23; ++u) { const int t = t0 - 30 + hb * 23 + u; const int tc = t >= 0 ? t : 0; const bf16_t* zr = A.Z + (size_t)(b * SEQ + tc) * NZ + ZCV; ra[u] = zr[c]; rg[u] = zr[256 + c]; }
#pragma unroll
            for (int u = 0; u < 23; ++u) { const int t = t0 - 30 + hb * 23 + u; gl[(hb * 23 + u) * 256 + c] = t >= 0 ? bf2f(ra[u]) * __builtin_amdgcn_rcpf(1.f + __expf(-bf2f(rg[u]))) : 0.f; } }
        __syncthreads();
        float y[16]; const float bias = A.dwb[c];
#pragma unroll
        for (int tt = 0; tt < 16; ++tt) y[tt] = bias;
        { float wk[31];
#pragma unroll
          for (int k = 0; k < 31; ++k) wk[k] = A.dw[k * 256 + c];
#pragma unroll
          for (int r = 0; r < 46; ++r) { const float gv = gl[r * 256 + c];
#pragma unroll
              for (int tt = 0; tt < 16; ++tt) { const int k = r - tt; if (k >= 0 && k < 31) y[tt] += wk[k] * gv; } } }
#pragma unroll
        for (int tt = 0; tt < 16; ++tt) { const float s = wave_sum(y[tt]); if ((c & 63) == 0) red[tt * 4 + wv] = s; }
        __syncthreads();
        float mu[16];
#pragma unroll
        for (int tt = 0; tt < 16; ++tt) mu[tt] = (red[tt * 4] + red[tt * 4 + 1] + red[tt * 4 + 2] + red[tt * 4 + 3]) * (1.f / 256.f);
        __syncthreads();
#pragma unroll
        for (int tt = 0; tt < 16; ++tt) { const float d = y[tt] - mu[tt]; const float s = wave_sum(d * d); if ((c & 63) == 0) red[tt * 4 + wv] = s; }
        __syncthreads();
        const float g = A.lng[c], bt = A.lnb[c];
#pragma unroll
        for (int tt = 0; tt < 16; ++tt) { const float var = (red[tt * 4] + red[tt * 4 + 1] + red[tt * 4 + 2] + red[tt * 4 + 3]) * (1.f / 256.f);
            const float v = (y[tt] - mu[tt]) * rsqrtf(var + 1e-6f) * g + bt;
            A.YCV[(size_t)(b * SEQ + t0 + tt) * 256 + c] = v * sigmoidf_(v); }
    }
}

struct GnArgs { const float* YATT; const float* Hloc; const float* Pc; const float* CIN; const bf16_t* Z; const float* YCV; const float* gout; bf16_t* Y; };
__device__ __forceinline__ void ph_groupnorm(const GnArgs& A) {
    int tid_ = phase_tid(); const int lane = tid_ & 63, wv = tid_ >> 6;
    for (int m0 = (blockIdx.x * 8 + wv) * 2; m0 < MTOK; m0 += gridDim.x * 16) {
        float4 a0[2], a1[2], hl[2], pc[2], ci[2], cvv[2]; uint2 gz[2];
#pragma unroll
        for (int r = 0; r < 2; ++r) { const int m = m0 + r, b = m / SEQ, t = m % SEQ; const int c0 = lane * 4;
            const float4* ya = (const float4*)(A.YATT + (size_t)m * 512) + lane * 2; a0[r] = ya[0]; a1[r] = ya[1];
            const size_t o = (size_t)m * 256 + c0; hl[r] = *(const float4*)(A.Hloc + o); pc[r] = *(const float4*)(A.Pc + o);
            ci[r] = *(const float4*)(A.CIN + (size_t)(b * 512 + (t >> 5)) * 256 + c0); gz[r] = *(const uint2*)(A.Z + (size_t)m * NZ + ZLG + c0);
            cvv[r] = *(const float4*)(A.YCV + (size_t)m * 256 + c0); }
#pragma unroll
        for (int r = 0; r < 2; ++r) { const int m = m0 + r; const int c0 = lane * 4;
            { const float4 x0 = a0[r], x1 = a1[r];
              const float s = (x0.x * x0.x + x0.y * x0.y) + (x0.z * x0.z + x0.w * x0.w) + (x1.x * x1.x + x1.y * x1.y) + (x1.z * x1.z + x1.w * x1.w);
              const float ra = rsqrtf(wave_sum(s) * (1.f / 512.f) + 1e-6f);
              const float* g = A.gout + lane * 8; uint4 w;
              w.x = f2bf(x0.x * ra * g[0]) | (f2bf(x0.y * ra * g[1]) << 16); w.y = f2bf(x0.z * ra * g[2]) | (f2bf(x0.w * ra * g[3]) << 16);
              w.z = f2bf(x1.x * ra * g[4]) | (f2bf(x1.y * ra * g[5]) << 16); w.w = f2bf(x1.z * ra * g[6]) | (f2bf(x1.w * ra * g[7]) << 16);
              *((uint4*)(A.Y + (size_t)m * 1024) + lane) = w; }
            { float y0 = (hl[r].x + pc[r].x * ci[r].x) * gelu_tanh(bf2f(gz[r].x & 0xffff)), y1 = (hl[r].y + pc[r].y * ci[r].y) * gelu_tanh(bf2f(gz[r].x >> 16));
              float y2 = (hl[r].z + pc[r].z * ci[r].z) * gelu_tanh(bf2f(gz[r].y & 0xffff)), y3 = (hl[r].w + pc[r].w * ci[r].w) * gelu_tanh(bf2f(gz[r].y >> 16));
              const float rl = rsqrtf(wave_sum(y0 * y0 + y1 * y1 + y2 * y2 + y3 * y3) * (1.f / 256.f) + 1e-6f);
              const float* g = A.gout + 512 + c0; uint2 w; w.x = f2bf(y0 * rl * g[0]) | (f2bf(y1 * rl * g[1]) << 16); w.y = f2bf(y2 * rl * g[2]) | (f2bf(y3 * rl * g[3]) << 16);
              *((uint2*)(A.Y + (size_t)m * 1024 + 512) + lane) = w; }
            { const float4 v = cvv[r];
              const float rc = rsqrtf(wave_sum(v.x * v.x + v.y * v.y + v.z * v.z + v.w * v.w) * (1.f / 256.f) + 1e-6f);
              const float* g = A.gout + 768 + c0; uint2 w; w.x = f2bf(v.x * rc * g[0]) | (f2bf(v.y * rc * g[1]) << 16); w.y = f2bf(v.z * rc * g[2]) | (f2bf(v.w * rc * g[3]) << 16);
              *((uint2*)(A.Y + (size_t)m * 1024 + 768) + lane) = w; } }
    }
}

constexpr size_t MiB = 1u << 20;
constexpr size_t WS_WIN = 1 * MiB;
constexpr size_t WS_WOUT = 11 * MiB;
constexpr size_t WS_W1 = 15 * MiB;
constexpr size_t WS_W2 = 31 * MiB;
constexpr size_t WS_RSTD = 47 * MiB;
constexpr size_t WS_LRUS = 48 * MiB;
constexpr size_t WS_WC1 = 52 * MiB;
constexpr size_t WS_W2P = 54 * MiB;
constexpr size_t WS_CB = 55 * MiB;
constexpr size_t WS_XN = 65 * MiB;
constexpr size_t WS_Z = 129 * MiB;
constexpr size_t WS_GATES = 273 * MiB;
constexpr size_t WS_KC = 276 * MiB, WS_VC = 277 * MiB;
constexpr size_t WS_YATT = 278 * MiB;
constexpr size_t WS_HLOC = 342 * MiB;
constexpr size_t WS_YCV = 374 * MiB;
constexpr size_t WS_Y = 406 * MiB;
constexpr size_t WS_PC = 470 * MiB;
constexpr size_t WS_H = 129 * MiB;
constexpr size_t WS_END = 502 * MiB;
constexpr int MEGA_LDS = MEGA_CTL + 512;
constexpr size_t WS_CTL = 0;
constexpr size_t CTL_BYTES = 131072;

#ifndef PROBE_REP
#define PROBE_REP 0
#endif
#define NREP(cls) (((PROBE_REP >> (cls)) & 1) ? 2 : 1)
struct MegaParams { const float* in[24]; float* out; unsigned char* ws; };

#define AS4 __attribute__((address_space(4)))
typedef const float* cfloat_p; typedef float* float_p; typedef unsigned char* uchar_p;
#define ARGS() const AS4 unsigned char* ka_ = (const AS4 unsigned char*)__builtin_amdgcn_kernarg_segment_ptr(); asm volatile("" : "+s"(ka_))
#define IN(k) (*(const AS4 cfloat_p*)(ka_ + 8 * (k)))
#define OUTP (*(const AS4 float_p*)(ka_ + 192))
#define WSP (*(const AS4 uchar_p*)(ka_ + 200))
__global__ void __launch_bounds__(512, 2) mega_fwd(MegaParams p) {
    LAS3 unsigned char* lds = (LAS3 unsigned char*)g_lds_raw;
    cg::grid_group grid = cg::this_grid();
#define G ((int)gridDim.x)
#define bid ((int)blockIdx.x)
    if (threadIdx.x < 64) ((LAS3 unsigned*)(lds + MEGA_CTL))[threadIdx.x] = 0u;
    if ((threadIdx.x & 63) == 0) ((LAS3 int*)(lds + MEGA_CTL))[64 + hw_wave_slot()] = (int)(threadIdx.x >> 6);
    __syncthreads();
    (void)xcd_barrier_post((unsigned*)(p.ws + WS_CTL), (volatile LAS unsigned*)(lds + MEGA_CTL));
#define XBAR_NOW() XcdBarrier xbar; { ARGS(); xbar.bar = (unsigned*)(WSP + WS_CTL); xbar.x = xb_xcc_id(); xbar.st = (volatile LAS unsigned*)(lds + MEGA_CTL); }
#define STAMP() do { } while (0)
#ifdef PROBE_TSEC
    int nbar_ = 0;
#define GSYNC() do { const unsigned long long tb0_ = __builtin_amdgcn_s_memrealtime(); XBAR_NOW(); xcd_barrier(xbar); if (bid == PROBE_TBLK && phase_tid() == 0) ((unsigned long long*)(p.ws + 98304))[nbar_] = __builtin_amdgcn_s_memrealtime() - tb0_; ++nbar_; } while (0)
#else
#define GSYNC() do { XBAR_NOW(); xcd_barrier(xbar); STAMP(); } while (0)
#endif

    for (int rep = 0; rep < NREP(0); ++rep)
    for (int l = 0; l < 2; ++l) {
        { ARGS(); const float* wi = IN(2) + (size_t)l * D_MODEL * N_IN; bf16_t* WinT = (bf16_t*)(WSP + WS_WIN) + (size_t)l * NZP * 1024;
          { TrJob J{wi, WinT, 1024, N_IN, 0, 0, 1280 / 32, 1024 / 32}; ph_transpose(J, lds); }
          { TrJob J{wi, WinT, 1024, N_IN, OFF_LRU_SRC, 1280, 1024 / 32, 1024 / 32}; ph_transpose(J, lds); }
          { TrJob J{wi, WinT, 1024, N_IN, OFF_GATE_SRC, NZ, 1, 1024 / 32}; ph_transpose(J, lds); }
          { uint4* zp = (uint4*)(WinT + (size_t)(NZ + 32) * 1024); for (int e = bid * 512 + phase_tid(); e < (NZP - NZ - 32) * 1024 / 8; e += G * 512) zp[e] = make_uint4(0u, 0u, 0u, 0u); } }
        { ARGS(); TrJob J{IN(20) + (size_t)l * 1024 * 1024, (bf16_t*)(WSP + WS_WOUT) + (size_t)l * 1024 * 1024, 1024, 1024, 0, 0, 1024 / 32, 1024 / 32}; ph_transpose(J, lds); }
        { ARGS(); TrJob J{IN(22) + (size_t)l * 1024 * 4096, (bf16_t*)(WSP + WS_W1) + (size_t)l * 4096 * 1024, 1024, 4096, 0, 0, 4096 / 32, 1024 / 32}; ph_transpose(J, lds); }
        { ARGS(); TrJob J{IN(23) + (size_t)l * 4096 * 1024, (bf16_t*)(WSP + WS_W2) + (size_t)l * 1024 * 4096, 4096, 1024, 0, 0, 1024 / 32, 4096 / 32}; ph_transpose(J, lds); }
        for (int kv = 0; kv < 2; ++kv) { ARGS(); TrJob J{IN(6) + (size_t)(l * 2 + kv) * 2048 * 128, (bf16_t*)(WSP + WS_WC1) + (size_t)(l * 2 + kv) * 128 * 2048, 2048, 128, 0, 0, 128 / 32, 2048 / 32}; ph_transpose(J, lds); }
        if (l == 0) { ARGS(); ph_cmp_prep(IN(5), IN(6), IN(7), (float*)(WSP + WS_CB), (bf16_t*)(WSP + WS_W2P)); }
    }
    for (int l = 0; l < 2; ++l) {
        for (int rep = 0; rep < NREP(9); ++rep) { ARGS(); ph_rmsnorm(l == 0 ? IN(0) : OUTP, IN(1) + l * 1024, (bf16_t*)(WSP + WS_XN), (float*)(WSP + WS_RSTD)); }
        if (l == 0) { grid.sync(); STAMP(); } else GSYNC();
        for (int rep = 0; rep < NREP(1); ++rep)
        { ARGS(); unsigned char* ws = WSP; pg8::Gemm g{(bf16_t*)(ws + WS_XN), (bf16_t*)(ws + WS_WIN) + (size_t)l * NZP * 1024, MTOK, NZP, 1024, 0}; pg8::StaticOrder S; S.init(MTOK, NZP, G, bid);
          pg8::EpiZ E{(bf16_t*)(ws + WS_Z), (float*)(ws + WS_GATES), NZ, 0};
          pg8::gemm_phase<pg8::EpiZ, pg8::StaticOrder, true, true>(lds, g, S, E, (unsigned long long*)(ws + 65536) + 16 * bid + 12); }
        GSYNC();
        { ARGS(); ph_qknorm((bf16_t*)(WSP + WS_Z), IN(3) + l * 64, IN(4) + l * 192); }
        for (int rep = 0; rep < NREP(2); ++rep) {
        for (int rep2 = 0; rep2 < NREP(10); ++rep2)
        { ARGS(); unsigned char* ws = WSP; Cmp2Args A{(bf16_t*)(ws + WS_Z), (bf16_t*)(ws + WS_WC1) + (size_t)l * 2 * 128 * 2048, (bf16_t*)(ws + WS_W2P) + (size_t)l * 2 * 8192, (float*)(ws + WS_CB) + l * 256, IN(4) + l * 192,
                                             (bf16_t*)(ws + WS_KC), (bf16_t*)(ws + WS_VC)}; ph_compress_mfma(A, lds); }
        for (int rep2 = 0; rep2 < NREP(11); ++rep2)
        { ARGS(); unsigned char* ws = WSP; float* SP = (float*)(ws + WS_LRUS);
          const LruArgs LA{(bf16_t*)(ws + WS_Z), IN(8) + l * 1024, IN(9) + l * 256, IN(10) + l * 8192, IN(11) + l * 256, IN(12) + l * 8192, IN(13) + l * 256, IN(14) + l * 256,
                           (float*)(ws + WS_HLOC), (float*)(ws + WS_PC), SP, SP + 2 * 512 * 256, SP + 4 * 512 * 256}; ph_lru1(LA, lds); }
        for (int rep2 = 0; rep2 < NREP(12); ++rep2)
        { ARGS(); ConvArgs A{(bf16_t*)(WSP + WS_Z), IN(15) + l * 31 * 256, IN(16) + l * 256, IN(17) + l * 256, IN(18) + l * 256, (float*)(WSP + WS_YCV)}; ph_conv(A, lds); }
        }
        GSYNC();
        if (bid < 16) { ARGS(); unsigned char* ws = WSP; float* SP = (float*)(ws + WS_LRUS);
            const LruArgs LA{nullptr, nullptr, nullptr, nullptr, nullptr, nullptr, nullptr, nullptr, nullptr, nullptr, SP, SP + 2 * 512 * 256, SP + 4 * 512 * 256}; ph_lru2(LA, lds, bid); }
        { ARGS(); unsigned char* ws = WSP; att::Tensors T{(bf16_t*)(ws + WS_Z), (bf16_t*)(ws + WS_KC), (bf16_t*)(ws + WS_VC), (float*)(ws + WS_GATES), (float*)(ws + WS_YATT), (unsigned long long*)(ws + 65536) + 16 * bid};
          for (int rep = 0; rep < NREP(3); ++rep)
          if (G == 256) {
              const int x = bid & 7, i = bid >> 3, bhx = x & 3, h2 = x >> 2;
              for (int it = 0; it < 4; ++it) { const int kk = it == 0 ? 127 - i : (it == 1 ? 64 + i : (it == 2 ? 63 - i : i)); att::attn_item(lds, T, bhx >> 1, bhx & 1, 2 * kk + h2); }
          } else {
              for (int c = bid; c < 256; c += G)
                  for (int it = 0; it < 4; ++it) { const int tile = (it & 1) ? 255 - c : c; att::attn_item(lds, T, it >> 1, it & 1, tile); }
          } }
        GSYNC();
        for (int rep = 0; rep < NREP(4); ++rep)
        { ARGS(); unsigned char* ws = WSP; GnArgs A{(float*)(ws + WS_YATT), (float*)(ws + WS_HLOC), (float*)(ws + WS_PC), (float*)(ws + WS_LRUS) + 4 * 512 * 256, (bf16_t*)(ws + WS_Z), (float*)(ws + WS_YCV), IN(19) + l * 1024, (bf16_t*)(ws + WS_Y)};
          ph_groupnorm(A); }
        GSYNC();
        { ARGS(); unsigned char* ws = WSP; pg8::Gemm g{(bf16_t*)(ws + WS_Y), (bf16_t*)(ws + WS_WOUT) + (size_t)l * 1024 * 1024, MTOK, 1024, 1024, 0}; pg8::StaticOrder S; S.init(MTOK, 1024, G, bid);
          pg8::EpiResF32 E{l == 0 ? IN(0) : OUTP, OUTP, 1024, 0};
          pg8::gemm_phase<pg8::EpiResF32, pg8::StaticOrder, true, true>(lds, g, S, E, (unsigned long long*)(ws + 65536) + 16 * bid + 13); }
        GSYNC();
        for (int rep = 0; rep < NREP(6); ++rep) { ARGS(); ph_rmsnorm(OUTP, IN(21) + l * 1024, (bf16_t*)(WSP + WS_XN), (float*)(WSP + WS_RSTD)); }
        GSYNC();
        for (int rep = 0; rep < NREP(7); ++rep)
        { ARGS(); unsigned char* ws = WSP; pg8::Gemm g{(bf16_t*)(ws + WS_XN), (bf16_t*)(ws + WS_W1) + (size_t)l * 4096 * 1024, MTOK, 4096, 1024, 0}; pg8::StaticOrder S; S.init(MTOK, 4096, G, bid); pg8::EpiBf16<2> E{(bf16_t*)(ws + WS_H), 4096, 0};
          pg8::gemm_phase<pg8::EpiBf16<2>, pg8::StaticOrder, true, true>(lds, g, S, E, (unsigned long long*)(ws + 65536) + 16 * bid + 14); }
        GSYNC();
        { ARGS(); unsigned char* ws = WSP; pg8::Gemm g{(bf16_t*)(ws + WS_H), (bf16_t*)(ws + WS_W2) + (size_t)l * 1024 * 4096, MTOK, 1024, 4096, 0}; pg8::StaticOrder S; S.init(MTOK, 1024, G, bid); pg8::EpiResF32 E{OUTP, OUTP, 1024, 0};
          pg8::gemm_phase<pg8::EpiResF32, pg8::StaticOrder, true, true>(lds, g, S, E, (unsigned long long*)(ws + 65536) + 16 * bid + 15); }
        if (l == 0) GSYNC();
    }
#ifdef PROBE_BARSEL
    if (bid == PROBE_TBLK && phase_tid() == 0) { unsigned long long w_ = 0; for (int k = 0; k < 32; ++k) if ((PROBE_BARSEL >> k) & 1) w_ += ((const unsigned long long*)(p.ws + 98304))[k];
        const unsigned long long t0_ = __builtin_amdgcn_s_memrealtime(); while (__builtin_amdgcn_s_memrealtime() - t0_ < w_) __builtin_amdgcn_s_sleep(8); }
#endif
#ifdef PROBE_TSEC
    if (bid == PROBE_TBLK && phase_tid() == 0) { const unsigned long long* ts_ = (const unsigned long long*)(p.ws + 65536) + 16 * bid; unsigned long long w_ = 0;
        for (int k = 0; k < 16; ++k) if ((PROBE_TSEC >> k) & 1) w_ += ts_[k];
        const unsigned long long t0_ = __builtin_amdgcn_s_memrealtime(); while (__builtin_amdgcn_s_memrealtime() - t0_ < w_) __builtin_amdgcn_s_sleep(8); }
#endif
}

#undef G
#undef bid
extern "C" void kernel_launch(void* const* d_in, const int* in_sizes, int n_in, void* d_out, int out_size, void* d_ws, size_t ws_size, hipStream_t stream) {
    if (n_in != 24 || in_sizes[0] != MTOK * D_MODEL || out_size != MTOK * D_MODEL || ws_size < WS_END) {
        fprintf(stderr, "kernel_launch: unexpected shapes: n_in %d in0 %d out %d ws %zu (need %zu)\n", n_in, n_in > 0 ? in_sizes[0] : -1, out_size, ws_size, (size_t)WS_END); return; }
    static int grid_blocks = 0;
    if (!grid_blocks) {
        int dev = 0, cus = 0, per_cu = 0;
        (void)hipGetDevice(&dev);
        (void)hipDeviceGetAttribute(&cus, hipDeviceAttributeMultiprocessorCount, dev);
        (void)hipFuncSetAttribute((const void*)mega_fwd, hipFuncAttributeMaxDynamicSharedMemorySize, MEGA_LDS);
        (void)hipOccupancyMaxActiveBlocksPerMultiprocessor(&per_cu, (const void*)mega_fwd, 512, MEGA_LDS);
        if (per_cu < 1) { fprintf(stderr, "kernel_launch: occupancy query returned %d\n", per_cu); per_cu = 1; }
        if (per_cu > 1) per_cu = 1;
        grid_blocks = cus * per_cu;
    }
    (void)hipMemsetAsync((unsigned char*)d_ws + WS_CTL, 0, CTL_BYTES, stream);
    MegaParams p{};
    for (int i = 0; i < 24; ++i) p.in[i] = (const float*)d_in[i];
    p.out = (float*)d_out; p.ws = (unsigned char*)d_ws;
    void* args[] = {&p};
    hipError_t e = hipLaunchCooperativeKernel((const void*)mega_fwd, dim3(grid_blocks), dim3(512), args, MEGA_LDS, stream);
    if (e != hipSuccess) fprintf(stderr, "cooperative launch failed: %s (grid %d)\n", hipGetErrorString(e), grid_blocks);
}
```
